# Optimizing an MI355X kernel written in HIP

```python
import math
import jax, jax.numpy as jnp
from jax import lax
import numpy as np

D_MODEL = 1024
BATCH = 32
SEQ = 256
DEPTH = 4
DEC_BATCH = 8
DEC_SEQ = 1024
PAST_LEN = 512

GRID_W = 64
Q_BLOCK = 128
ROPE_BASE = 10000.0
EPS = 1e-6
A_HEADS = 4
A_KV_HEADS = 2
A_HEAD_DIM = 64
B_HEADS = 4
B_KEY_DIM = 32
B_VAL_DIM = 64
B_GATE_RANK = 16
B_GATE_NORM = 16.0
B_CHUNK = 64
C_HEADS = 4
C_HEAD_DIM = 32
D_HEADS = 4
D_NOPE_DIM = 64
D_ROPE_DIM = 32
D_V_DIM = 64
D_Q_RANK = 192
D_KV_RANK = 128
N_BRANCH = 4
BRANCH_WIDTH = 256
D_FF = 2816
CONV_W = 3

IN_SPLITS = (
    ('a_q', A_HEADS * A_HEAD_DIM), ('a_k', A_KV_HEADS * A_HEAD_DIM), ('a_v', A_KV_HEADS * A_HEAD_DIM),
    ('b_q', B_HEADS * B_KEY_DIM), ('b_k', B_HEADS * B_KEY_DIM), ('b_v', B_HEADS * B_VAL_DIM),
    ('b_r', B_HEADS * B_VAL_DIM), ('b_gf', B_GATE_RANK), ('b_gb', B_GATE_RANK),
    ('c_q', C_HEADS * 2 * C_HEAD_DIM), ('c_k', C_HEADS * 2 * C_HEAD_DIM), ('c_v', C_HEADS * 2 * C_HEAD_DIM),
    ('d_q', D_Q_RANK), ('d_kv', D_KV_RANK), ('d_kr', D_ROPE_DIM),
    ('gates', N_BRANCH * D_MODEL),
)

kernel_name = 'hybrid_diffusion_prefix_trunk_step'


def split_cols(z):
    out = {}
    off = 0
    for name, w in IN_SPLITS:
        out[name] = z[..., off:off + w]
        off += w
    return out


def rmsnorm(x, g):
    xf = x.astype(jnp.float32)
    y = xf * lax.rsqrt(jnp.mean(xf * xf, axis=-1, keepdims=True) + EPS)
    return (y * g.astype(jnp.float32)).astype(x.dtype)


def grid_positions(n):
    rows = n // GRID_W
    t = jnp.arange(rows * GRID_W)
    return (t // GRID_W).astype(jnp.float32), (t % GRID_W).astype(jnp.float32)


def rope_1d(x, pos):
    half = x.shape[-1] // 2
    inv = ROPE_BASE ** (-jnp.arange(half, dtype=jnp.float32) / half)
    ang = pos[:, None] * inv[None, :]
    shape = (1, pos.shape[0]) + (1,) * (x.ndim - 3) + (half,)
    cos = jnp.cos(ang).reshape(shape)
    sin = jnp.sin(ang).reshape(shape)
    xf = x.astype(jnp.float32)
    x1, x2 = xf[..., :half], xf[..., half:]
    return jnp.concatenate([x1 * cos - x2 * sin, x2 * cos + x1 * sin], axis=-1).astype(x.dtype)


def rope_2d(x, row, col):
    r = x.shape[-1] // 2
    return jnp.concatenate([rope_1d(x[..., :r], row), rope_1d(x[..., r:], col)], axis=-1)


def sweep_q_blocks(fn, qs):
    b, sq = qs[0].shape[:2]
    nb = sq // Q_BLOCK
    blocks = tuple(jnp.moveaxis(q.reshape((b, nb, Q_BLOCK) + q.shape[2:]), 1, 0) for q in qs)
    out = jnp.moveaxis(lax.map(fn, blocks), 0, 1)
    return out.reshape((b, sq) + out.shape[3:])


def gqa_attention(q, k, v, scale):
    def block(qb):
        (qb,) = qb
        s = jnp.einsum('bqhgd,bkhd->bhgqk', qb, k).astype(jnp.float32) * scale
        p = jax.nn.softmax(s, axis=-1).astype(v.dtype)
        return jnp.einsum('bhgqk,bkhd->bqhgd', p, v)
    return sweep_q_blocks(block, (q,))


def diff_attention(q, k, v, lam, scale):
    def block(qb):
        (qb,) = qb
        s = jnp.einsum('bqhjd,bkhjd->bhjqk', qb, k).astype(jnp.float32) * scale
        p = jax.nn.softmax(s, axis=-1)
        a = (p[:, :, 0] - lam * p[:, :, 1]).astype(v.dtype)
        return jnp.einsum('bhqk,bkhe->bqhe', a, v)
    return sweep_q_blocks(block, (q,))


def gla_scan(q, k, v, logg, s0):
    f32 = jnp.float32
    bsz, n, h, dk = q.shape
    dv = v.shape[-1]
    nc = n // B_CHUNK
    ch = lambda t: t.reshape((bsz, nc, B_CHUNK) + t.shape[2:]).astype(f32)
    qc, kc, vc = ch(q), ch(k), ch(v)
    bc = jnp.cumsum(ch(logg), axis=2)
    b_last = bc[:, :, -1]
    causal = jnp.tril(jnp.ones((B_CHUNK, B_CHUNK), bool))[None, None, :, :, None, None]
    expo = bc[:, :, :, None] - bc[:, :, None, :]
    decay = jnp.exp(jnp.where(causal, expo, -jnp.inf))
    attn = jnp.einsum('bcthd,bcshd,bctshd->bchts', qc, kc, decay)
    o_intra = jnp.einsum('bchts,bcshe->bcthe', attn, vc)
    q_dec = qc * jnp.exp(bc)
    k_dec = kc * jnp.exp(b_last[:, :, None] - bc)
    ds = jnp.einsum('bcshd,bcshe->bchde', k_dec, vc)
    g_last = jnp.exp(b_last)

    def step(s, inp):
        g, d = inp
        return g[..., None] * s + d, s

    s_fin, s_in = lax.scan(step, s0.astype(f32), (jnp.moveaxis(g_last, 1, 0), jnp.moveaxis(ds, 1, 0)))
    s_in = jnp.moveaxis(s_in, 0, 1)
    o_inter = jnp.einsum('bcthd,bchde->bcthe', q_dec, s_in)
    o = (o_intra + o_inter).reshape(bsz, n, h, dv)
    return o.astype(v.dtype), s_fin


def gla_bidir(q, k, v, lg_f, lg_b, s0_f, s0_b):
    o_f, s_f = gla_scan(q, k, v, lg_f, s0_f)
    flip = lambda t: jnp.flip(t, axis=1)
    o_b, s_b = gla_scan(flip(q), flip(k), flip(v), flip(lg_b), s0_b)
    return o_f + flip(o_b), s_f, s_b


def mixing_block(h, p, lam_init, pos, ctx):
    f32 = jnp.float32
    bsz, n, _ = h.shape
    z = split_cols(h @ p['w_in'])
    aq = rmsnorm(z['a_q'].reshape(bsz, n, A_KV_HEADS, A_HEADS // A_KV_HEADS, A_HEAD_DIM), p['a_qnorm_g'])
    ak = rmsnorm(z['a_k'].reshape(bsz, n, A_KV_HEADS, A_HEAD_DIM), p['a_knorm_g'])
    av = z['a_v'].reshape(bsz, n, A_KV_HEADS, A_HEAD_DIM)
    bq = z['b_q'].reshape(bsz, n, B_HEADS, B_KEY_DIM) * (B_KEY_DIM ** -0.5)
    bk = z['b_k'].reshape(bsz, n, B_HEADS, B_KEY_DIM)
    bv = z['b_v'].reshape(bsz, n, B_HEADS, B_VAL_DIM)
    lg_f = (jax.nn.log_sigmoid((z['b_gf'] @ p['b_gate_w_fwd'] + p['b_gate_b_fwd']).astype(f32)) / B_GATE_NORM).reshape(bsz, n, B_HEADS, B_KEY_DIM)
    lg_b = (jax.nn.log_sigmoid((z['b_gb'] @ p['b_gate_w_bwd'] + p['b_gate_b_bwd']).astype(f32)) / B_GATE_NORM).reshape(bsz, n, B_HEADS, B_KEY_DIM)
    cq = z['c_q'].reshape(bsz, n, C_HEADS, 2, C_HEAD_DIM)
    ck = z['c_k'].reshape(bsz, n, C_HEADS, 2, C_HEAD_DIM)
    cv = z['c_v'].reshape(bsz, n, C_HEADS, 2 * C_HEAD_DIM)
    dq = (rmsnorm(z['d_q'], p['d_qnorm_g']) @ p['d_w_uq']).reshape(bsz, n, D_HEADS, D_NOPE_DIM + D_ROPE_DIM)
    dckv = rmsnorm(z['d_kv'], p['d_kvnorm_g'])
    dkr = z['d_kr']
    if pos is not None:
        row, col = pos
        aq = rope_2d(aq, row, col)
        ak = rope_2d(ak, row, col)
        cq = rope_2d(cq, row, col)
        ck = rope_2d(ck, row, col)
        dq = jnp.concatenate([dq[..., :D_NOPE_DIM], rope_2d(dq[..., D_NOPE_DIM:], row, col)], axis=-1)
        dkr = rope_2d(dkr, row, col)
    if ctx is None:
        ak_all, av_all, ck_all, cv_all, ckv_all, kr_all = ak, av, ck, cv, dckv, dkr
        s0_f = jnp.zeros((bsz, B_HEADS, B_KEY_DIM, B_VAL_DIM), f32)
        s0_b = s0_f
    else:
        c_ak, c_av, s0_f, s0_b, c_ck, c_cv, c_ckv, c_kr = ctx
        cat = lambda a, b: jnp.concatenate([a.astype(b.dtype), b], axis=1)
        ak_all, av_all = cat(c_ak, ak), cat(c_av, av)
        ck_all, cv_all = cat(c_ck, ck), cat(c_cv, cv)
        ckv_all, kr_all = cat(c_ckv, dckv), cat(c_kr, dkr)
    oa = gqa_attention(aq, ak_all, av_all, A_HEAD_DIM ** -0.5).reshape(bsz, n, BRANCH_WIDTH)
    ob_raw, s_f, s_b = gla_bidir(bq, bk, bv, lg_f, lg_b, s0_f, s0_b)
    ob = (rmsnorm(ob_raw, p['b_onorm_g']) * jax.nn.silu(z['b_r'].reshape(bsz, n, B_HEADS, B_VAL_DIM))).reshape(bsz, n, BRANCH_WIDTH)
    lam = (jnp.exp(jnp.sum(p['c_lq1'].astype(f32) * p['c_lk1'].astype(f32)))
           - jnp.exp(jnp.sum(p['c_lq2'].astype(f32) * p['c_lk2'].astype(f32))) + lam_init)
    oc_raw = diff_attention(cq, ck_all, cv_all, lam, C_HEAD_DIM ** -0.5)
    oc = (rmsnorm(oc_raw, p['c_onorm_g']) * (1.0 - lam_init)).reshape(bsz, n, BRANCH_WIDTH)
    kv_up = (ckv_all @ p['d_w_ukv']).reshape(bsz, -1, D_HEADS, D_NOPE_DIM + D_V_DIM)
    sk = kv_up.shape[1]
    dk_full = jnp.concatenate([kv_up[..., :D_NOPE_DIM],
                               jnp.broadcast_to(kr_all[:, :, None].astype(kv_up.dtype), (bsz, sk, D_HEADS, D_ROPE_DIM))], axis=-1)
    dv_all = kv_up[..., D_NOPE_DIM:]
    od = gqa_attention(dq[:, :, :, None], dk_full, dv_all, (D_NOPE_DIM + D_ROPE_DIM) ** -0.5).reshape(bsz, n, BRANCH_WIDTH)
    branches = jnp.stack([oa, ob, oc, od], axis=2)
    proj = jnp.einsum('bnjw,jwd->bnjd', branches, p['w_branch'])
    gates = jax.nn.sigmoid(z['gates'].reshape(bsz, n, N_BRANCH, D_MODEL).astype(f32)).astype(proj.dtype)
    out = jnp.sum(gates * proj, axis=2) @ p['w_out']
    return out, (ak, av, s_f, s_b, ck, cv, dckv, dkr)


def conv_ffn(h, p):
    u = h @ p['w_ffu']
    g = h @ p['w_ffg']
    up = jnp.pad(u, ((0, 0), (1, 1), (0, 0)))
    w = p['conv_w']
    u = up[:, :-2] * w[0] + up[:, 1:-1] * w[1] + up[:, 2:] * w[2] + p['conv_b']
    return (jax.nn.gelu(u) * g) @ p['w_ffd']


def trunk_layer(x, cvec, p, lam_init, pos, ctx):
    mod = jax.nn.silu(cvec) @ p['w_mod'] + p['b_mod']
    sh1, sc1, g1, sh2, sc2, g2 = jnp.split(mod[:, None, :], 6, axis=-1)
    h = rmsnorm(x, p['norm1_g']) * (1.0 + sc1) + sh1
    mix, cache = mixing_block(h, p, lam_init, pos, ctx)
    x = x + g1 * mix
    h = rmsnorm(x, p['norm2_g']) * (1.0 + sc2) + sh2
    x = x + g2 * conv_ffn(h, p)
    return x, cache


def setup_inputs(seed: int = 0) -> dict:
    key = jax.random.key(seed)
    keys = jax.random.split(key, 64)
    cnt = [0]

    def nrm(shape, scale=1.0):
        k = keys[cnt[0]]
        cnt[0] += 1
        return jax.random.normal(k, shape, jnp.float32) * scale

    def gain(shape):
        return 1.0 + nrm(shape, 0.02)

    in_width = sum(w for _, w in IN_SPLITS)
    L = DEPTH
    return {
        'x_prompt': nrm((BATCH, SEQ, D_MODEL)),
        'x_sample': nrm((DEC_BATCH, DEC_SEQ, D_MODEL)),
        'c': nrm((DEC_BATCH, D_MODEL)),
        'cache_a_k': nrm((DEC_BATCH, L, PAST_LEN, A_KV_HEADS, A_HEAD_DIM)),
        'cache_a_v': nrm((DEC_BATCH, L, PAST_LEN, A_KV_HEADS, A_HEAD_DIM)),
        'state_b_fwd': nrm((DEC_BATCH, L, B_HEADS, B_KEY_DIM, B_VAL_DIM), 0.5),
        'state_b_bwd': nrm((DEC_BATCH, L, B_HEADS, B_KEY_DIM, B_VAL_DIM), 0.5),
        'cache_c_k': nrm((DEC_BATCH, L, PAST_LEN, C_HEADS, 2, C_HEAD_DIM)),
        'cache_c_v': nrm((DEC_BATCH, L, PAST_LEN, C_HEADS, 2 * C_HEAD_DIM)),
        'cache_d_ckv': nrm((DEC_BATCH, L, PAST_LEN, D_KV_RANK)),
        'cache_d_krope': nrm((DEC_BATCH, L, PAST_LEN, D_ROPE_DIM)),
        'c_ctx': nrm((D_MODEL,)),
        'w_mod': nrm((L, D_MODEL, 6 * D_MODEL), 0.5 * D_MODEL ** -0.5),
        'b_mod': nrm((L, 6 * D_MODEL), 0.02),
        'norm1_g': gain((L, D_MODEL)),
        'norm2_g': gain((L, D_MODEL)),
        'w_in': nrm((L, D_MODEL, in_width), D_MODEL ** -0.5),
        'a_qnorm_g': gain((L, A_HEAD_DIM)),
        'a_knorm_g': gain((L, A_HEAD_DIM)),
        'b_gate_w_fwd': nrm((L, B_GATE_RANK, B_HEADS * B_KEY_DIM), B_GATE_RANK ** -0.5),
        'b_gate_b_fwd': nrm((L, B_HEADS * B_KEY_DIM), 0.1),
        'b_gate_w_bwd': nrm((L, B_GATE_RANK, B_HEADS * B_KEY_DIM), B_GATE_RANK ** -0.5),
        'b_gate_b_bwd': nrm((L, B_HEADS * B_KEY_DIM), 0.1),
        'b_onorm_g': gain((L, B_VAL_DIM)),
        'c_lq1': nrm((L, C_HEAD_DIM), 0.1),
        'c_lk1': nrm((L, C_HEAD_DIM), 0.1),
        'c_lq2': nrm((L, C_HEAD_DIM), 0.1),
        'c_lk2': nrm((L, C_HEAD_DIM), 0.1),
        'c_onorm_g': gain((L, 2 * C_HEAD_DIM)),
        'd_qnorm_g': gain((L, D_Q_RANK)),
        'd_w_uq': nrm((L, D_Q_RANK, D_HEADS * (D_NOPE_DIM + D_ROPE_DIM)), D_Q_RANK ** -0.5),
        'd_kvnorm_g': gain((L, D_KV_RANK)),
        'd_w_ukv': nrm((L, D_KV_RANK, D_HEADS * (D_NOPE_DIM + D_V_DIM)), D_KV_RANK ** -0.5),
        'w_branch': nrm((L, N_BRANCH, BRANCH_WIDTH, D_MODEL), BRANCH_WIDTH ** -0.5),
        'w_out': nrm((L, D_MODEL, D_MODEL), D_MODEL ** -0.5),
        'w_ffu': nrm((L, D_MODEL, D_FF), D_MODEL ** -0.5),
        'w_ffg': nrm((L, D_MODEL, D_FF), D_MODEL ** -0.5),
        'conv_w': nrm((L, CONV_W, D_FF), CONV_W ** -0.5),
        'conv_b': nrm((L, D_FF), 0.02),
        'w_ffd': nrm((L, D_FF, D_MODEL), D_FF ** -0.5),
        'final_g': gain((D_MODEL,)),
    }


def reference(x_prompt, x_sample, c, cache_a_k, cache_a_v, state_b_fwd, state_b_bwd, cache_c_k, cache_c_v,
              cache_d_ckv, cache_d_krope, c_ctx, w_mod, b_mod, norm1_g, norm2_g, w_in, a_qnorm_g, a_knorm_g,
              b_gate_w_fwd, b_gate_b_fwd, b_gate_w_bwd, b_gate_b_bwd, b_onorm_g, c_lq1, c_lk1, c_lq2, c_lk2,
              c_onorm_g, d_qnorm_g, d_w_uq, d_kvnorm_g, d_w_ukv, w_branch, w_out, w_ffu, w_ffg, conv_w, conv_b,
              w_ffd, final_g):
    pos = grid_positions(x_sample.shape[1])
    xp, xs = x_prompt, x_sample
    ctx_vec = c_ctx[None, :]
    caches = []
    for l in range(DEPTH):
        p = {
            'w_mod': w_mod[l], 'b_mod': b_mod[l], 'norm1_g': norm1_g[l], 'norm2_g': norm2_g[l],
            'w_in': w_in[l], 'a_qnorm_g': a_qnorm_g[l], 'a_knorm_g': a_knorm_g[l],
            'b_gate_w_fwd': b_gate_w_fwd[l], 'b_gate_b_fwd': b_gate_b_fwd[l],
            'b_gate_w_bwd': b_gate_w_bwd[l], 'b_gate_b_bwd': b_gate_b_bwd[l], 'b_onorm_g': b_onorm_g[l],
            'c_lq1': c_lq1[l], 'c_lk1': c_lk1[l], 'c_lq2': c_lq2[l], 'c_lk2': c_lk2[l], 'c_onorm_g': c_onorm_g[l],
            'd_qnorm_g': d_qnorm_g[l], 'd_w_uq': d_w_uq[l], 'd_kvnorm_g': d_kvnorm_g[l], 'd_w_ukv': d_w_ukv[l],
            'w_branch': w_branch[l], 'w_out': w_out[l], 'w_ffu': w_ffu[l], 'w_ffg': w_ffg[l],
            'conv_w': conv_w[l], 'conv_b': conv_b[l], 'w_ffd': w_ffd[l],
        }
        lam_init = 0.8 - 0.6 * math.exp(-0.3 * l)
        xp, cache_l = trunk_layer(xp, ctx_vec, p, lam_init, None, None)
        caches.append(cache_l)
        ctx_l = (cache_a_k[:, l], cache_a_v[:, l], state_b_fwd[:, l], state_b_bwd[:, l],
                 cache_c_k[:, l], cache_c_v[:, l], cache_d_ckv[:, l], cache_d_krope[:, l])
        xs, _ = trunk_layer(xs, c, p, lam_init, pos, ctx_l)
    y_prompt = rmsnorm(xp, final_g)
    y_sample = rmsnorm(xs, final_g)
    stack = lambda i: jnp.stack([cl[i] for cl in caches], axis=1)
    new_a_k = stack(0)
    new_a_v = stack(1)
    new_b_fwd = stack(2)
    new_b_bwd = stack(3)
    new_c_k = stack(4)
    new_c_v = stack(5)
    new_d_ckv = stack(6)
    new_d_krope = stack(7)
    return (y_prompt, y_sample, new_a_k, new_a_v, new_b_fwd, new_b_bwd, new_c_k, new_c_v, new_d_ckv, new_d_krope)
```

```cpp
#include <hip/hip_runtime.h>
#include <hip/hip_cooperative_groups.h>
#include <cstdio>
#include <cstdint>
namespace cg = cooperative_groups;

#define DI __device__ __forceinline__
#define LAS __attribute__((address_space(3)))
typedef unsigned short bf16_t;
typedef short bf16x8 __attribute__((ext_vector_type(8)));
typedef short s16x4 __attribute__((ext_vector_type(4)));
typedef float f32x4 __attribute__((ext_vector_type(4)));
typedef float f32x16 __attribute__((ext_vector_type(16)));
typedef float f32x2 __attribute__((ext_vector_type(2)));
typedef __bf16 bf16x2_t __attribute__((ext_vector_type(2)));
typedef unsigned u32x4 __attribute__((ext_vector_type(4)));
typedef unsigned u32x2 __attribute__((ext_vector_type(2)));

constexpr int T = 16384, TP = 8192, DM = 1024, NL = 4, FF = 2816, WIN = 6528;
constexpr int ZLD = 3072, N1 = 7168, NT_SMALL = 12, NWC = 640;
constexpr int ZC_AQ = 0, ZC_AK = 256, ZC_AV = 384, ZC_BQ = 512, ZC_BK = 640, ZC_BV = 768, ZC_BR = 1024, ZC_CQ = 1280, ZC_CK = 1536, ZC_CV = 1792,
              ZC_DQ = 2048, ZC_DKV = 2240, ZC_DKR = 2368, ZC_LGF = 2400, ZC_LGB = 2528, ZC_DQU = 2656;
constexpr float EPS = 1e-6f, LOG2E = 1.4426950408889634f;
constexpr size_t O_AK = 16777216, O_AV = 20971520, O_BF = 25165824, O_BB = 26214400, O_CK = 27262976, O_CV = 35651584, O_DCKV = 44040192, O_DKR = 48234496;
constexpr size_t SZ_Z = (size_t)T * ZLD * 2, SZ_U = (size_t)T * FF * 2;
constexpr size_t WS_Z = 0, WS_U = 0, WS_G = SZ_U, WS_BR = SZ_Z, WS_OF = WS_BR + (size_t)T * 1024 * 2, SZ_RA = 2 * SZ_U;
static_assert(WS_OF + (size_t)2 * T * 256 * 4 <= SZ_RA, "region A");
constexpr size_t WS_R = SZ_RA, WS_ACT = SZ_RA, SZ_RB = (size_t)T * 4096 * 2;
constexpr size_t WS_RC = WS_R + SZ_RB;
constexpr size_t WS_HB = WS_RC;
constexpr size_t WS_QA = WS_RC, WS_KAN = WS_QA + (size_t)T * 256 * 2, WS_VAN = WS_KAN + (size_t)T * 128 * 2, WS_QC = WS_VAN + (size_t)T * 128 * 2,
                 WS_KCN = WS_QC + (size_t)T * 256 * 2, WS_VCN = WS_KCN + (size_t)T * 256 * 2, WS_QD = WS_VCN + (size_t)T * 256 * 2,
                 WS_KDN = WS_QD + (size_t)T * 384 * 2, WS_VDN = WS_KDN + (size_t)T * 384 * 2, WS_RW = WS_VDN + (size_t)T * 256 * 2;
constexpr size_t WS_W1 = WS_RW, WS_WBR = WS_W1 + (size_t)N1 * 1024 * 2, WS_WOUT = WS_WBR + (size_t)4 * 1024 * 256 * 2, WS_WUG = WS_WOUT + (size_t)1024 * 1024 * 2,
                 WS_WFD = WS_WUG + (size_t)5632 * 1024 * 2, WS_RK = WS_WFD + (size_t)1024 * FF * 2;
constexpr size_t WS_KAC = WS_RK, WS_VAC = WS_KAC + 4194304, WS_KCC = WS_VAC + 4194304, WS_VCC = WS_KCC + 8388608, WS_KDC = WS_VCC + 8388608,
                 WS_VDC = WS_KDC + 12582912, WS_CKVB = WS_VDC + 8388608, WS_WUKVT = WS_CKVB + 4194304, WS_WCT = WS_WUKVT + 524288,
                 WS_MOD = WS_WCT + (size_t)4 * NWC * 1024 * 2, WS_TAB = WS_MOD + (size_t)4 * 9 * 6144 * 4, WS_BAR = WS_TAB + 16384, WS_END = WS_BAR + 32768;
static_assert(WS_END < 505000000ull, "workspace budget");
constexpr int LDS_BYTES = 147456;
constexpr int NPHASE = 42;
#ifndef DUPU
#define DUPU 0
#endif
#ifndef DUPSYNC
#define DUPSYNC 0
#endif
#ifndef DUPMASK
#define DUPMASK 0
#endif
#ifndef PHM
#define PHM 1023
#endif

struct Params { const float* in[41]; float* out; unsigned char* ws; int ph_lo, ph_hi; };

#define MFMA16(a, b, c) __builtin_amdgcn_mfma_f32_16x16x32_bf16((a), (b), (c), 0, 0, 0)
DI int tidx() { int t = threadIdx.x; asm volatile("" : "+v"(t)); return t; }
DI float bf2f(bf16_t v) { return __uint_as_float(((unsigned)v) << 16); }
DI unsigned pk2(float lo, float hi) { f32x2 v = {lo, hi}; bf16x2_t b = __builtin_convertvector(v, bf16x2_t); return __builtin_bit_cast(unsigned, b); }
DI bf16_t f2bf(float f) { return (bf16_t)(pk2(f, 0.f) & 0xffffu); }
DI float wave_sum(float v) {
#pragma unroll
    for (int o = 1; o < 64; o <<= 1) v += __shfl_xor(v, o);
    return v;
}
DI void lds_barrier() { asm volatile("s_waitcnt lgkmcnt(0)" ::: "memory"); __builtin_amdgcn_s_barrier(); asm volatile("" ::: "memory"); }
DI float sigmoidf_(float x) { return 1.f / (1.f + __expf(-x)); }
DI float siluf_(float x) { return x / (1.f + __expf(-x)); }
DI float gelu_tanh(float x) { const float u = 0.7978845608028654f * (x + 0.044715f * x * x * x); const float e = __builtin_amdgcn_exp2f(u * (2.f * LOG2E)); return x * (1.f - __builtin_amdgcn_rcpf(e + 1.f)); }
DI float logsigmoidf_(float x) { return fminf(x, 0.f) - __logf(1.f + __expf(-fabsf(x))); }

namespace pg8 {
constexpr int BM = 256, BK = 64, HALF = 128, HTB = HALF * BK * 2, STAGE_BYTES = 8 * HTB, NXCD = 8, WGM = 8;
__host__ __device__ __forceinline__ int lds_byte(int r, int c) { const int st = (r >> 4) * 2 + (c >> 5), rr = r & 15, cc = c & 31, ob = rr * 64 + cc * 2; return st * 1024 + (ob ^ (((ob >> 9) & 1) << 5)); }
__host__ __device__ __forceinline__ void stage_rc(int b, int& R, int& C) { const int st = b / 1024, sb = b % 1024, swz = sb ^ (((sb >> 9) & 1) << 5); R = (st >> 1) * 16 + swz / 64; C = (st & 1) * 32 + (swz % 64) / 2; }
__host__ __device__ __forceinline__ int perm32(int rho) { const int n = rho >> 4, i = rho & 15; return 8 * (i >> 2) + 4 * n + (i & 3); }

struct Unit { int pm, pn, j; };
struct Gemm { const bf16_t* A; const bf16_t* Bt; int lda, ldb, K; size_t a_joff, b_joff; int a_tile_rows = 256; };

DI void tile_of(int L, int nM, int nN, int& pm, int& pn) {
    const int nwg = nM * nN; int wgid = L;
    { const int q = nwg / NXCD, r = nwg % NXCD, xcd = wgid % NXCD, off = wgid / NXCD; wgid = (xcd < r ? xcd * (q + 1) : r * (q + 1) + (xcd - r) * q) + off; }
    const int nig = WGM * nN, gid = wgid / nig, fm = gid * WGM, gsz = (nM - fm) < WGM ? (nM - fm) : WGM;
    pm = fm + ((wgid % nig) % gsz); pn = (wgid % nig) / gsz;
}
struct StaticOrder {
    int nM, nN, nwg, G, c, jmode;
    DI void init(int M, int N, int G_, int c_, int jm) { nM = M / BM; nN = N / BM; nwg = nM * nN; G = G_; c = c_; jmode = jm; }
    DI bool next(int i, Unit& u) const {
        const int ti = (jmode == 1) ? (i >> 2) : i;
        const long Lx = (long)ti * G + c; if (Lx >= nwg) return false;
        if (jmode == 3) { const int ng = nM * 16;
            if (Lx < ng) { tile_of((int)Lx, nM, 16, u.pm, u.pn); u.pn += nN - 16; } else tile_of((int)Lx - ng, nM, nN - 16, u.pm, u.pn);
            u.j = 0; return true; }
        tile_of((int)Lx, nM, nN, u.pm, u.pn);
        u.j = (jmode == 1) ? (i & 3) : (jmode == 2 ? (u.pm >> 4) : 0);
        return true;
    }
};

template <class Epi>
DI void gemm_phase(LAS unsigned char* lds, const Gemm g, const StaticOrder& S, Epi& E) {
    const int tid = tidx(), wid = __builtin_amdgcn_readfirstlane(tid >> 6), lane = tid & 63, wr = wid >> 2, wc = wid & 3, fr = lane & 15, fq = lane >> 4;
    int Kq = g.K; asm volatile("" : "+s"(Kq));
    const int K = Kq, nt = K / BK;
    unsigned voffA, voffB;
    { int R, C; stage_rc(tid * 16, R, C); const int Rb = (R & ~31) + perm32(R & 31); voffA = (unsigned)(R * g.lda + C) * 2u; voffB = (unsigned)(Rb * g.ldb + C) * 2u; }
    const size_t r64A = (size_t)64 * g.lda * 2, r64B = (size_t)64 * g.ldb * 2;
    const size_t kstep = (size_t)(BK * 2);
    const size_t hstepA = (size_t)HALF * g.lda * 2, hstepB = (size_t)HALF * g.ldb * 2;
    const size_t tstepA = (size_t)g.a_tile_rows * g.lda * 2, tstepB = 2 * hstepB;
    const unsigned ldsw = (unsigned)wid * 1024u;
    const int aoff = lds_byte(wr * 64 + fr, fq * 8), boff = lds_byte(wc * 32 + fr, fq * 8);
#define PG8_SA(b, h) (((b) * 2 + (h)) * HTB)
#define PG8_SB(b, h) ((4 + (b) * 2 + (h)) * HTB)
#define PG8_STAGE(bufoff, gbase, X) do { _Pragma("unroll") for (int _i = 0; _i < 2; ++_i) \
        __builtin_amdgcn_global_load_lds((const unsigned*)((const char*)(gbase) + _i * (r64##X) + (voff##X)), (LAS unsigned*)(lds + (bufoff) + ldsw + _i * 8192), 16, 0, 0); } while (0)
#define PG8_LDA(dst, b, h) do { _Pragma("unroll") for (int m = 0; m < 4; ++m) _Pragma("unroll") for (int k = 0; k < 2; ++k) dst[m][k] = *(const LAS bf16x8*)(lds + PG8_SA(b, h) + aoff + m * 2048 + k * 1024); } while (0)
#define PG8_LDB(dst, b, h) do { _Pragma("unroll") for (int n = 0; n < 2; ++n) _Pragma("unroll") for (int k = 0; k < 2; ++k) dst[n][k] = *(const LAS bf16x8*)(lds + PG8_SB(b, h) + boff + n * 2048 + k * 1024); } while (0)
#define PG8_MMA(ai, bj, At, Bt) do { __builtin_amdgcn_s_setprio(1); _Pragma("unroll") for (int m = 0; m < 4; ++m) _Pragma("unroll") for (int n = 0; n < 2; ++n) _Pragma("unroll") for (int k = 0; k < 2; ++k) \
        acc[ai][bj][m][n] = __builtin_amdgcn_mfma_f32_16x16x32_bf16(Bt[n][k], At[m][k], acc[ai][bj][m][n], 0, 0, 0); __builtin_amdgcn_s_setprio(0); } while (0)
#define PG8_WAIT_V(n) asm volatile("s_waitcnt vmcnt(" #n ")" ::: "memory")
#define PG8_WAIT_L(n) asm volatile("s_waitcnt lgkmcnt(" #n ")" ::: "memory")
#define PG8_BAR __builtin_amdgcn_s_barrier()
#define PG8_SCHED __builtin_amdgcn_sched_barrier(0)
    Unit cur, nxt; int ui = 0;
    if (!S.next(0, cur)) return;
    f32x4 acc[2][2][4][2];
#pragma unroll
    for (int a = 0; a < 2; ++a)
#pragma unroll
        for (int b = 0; b < 2; ++b)
#pragma unroll
            for (int m = 0; m < 4; ++m)
#pragma unroll
                for (int n = 0; n < 2; ++n) acc[a][b][m][n] = (f32x4){0.f, 0.f, 0.f, 0.f};
    bf16x8 At[4][2], B0[2][2], B1[2][2];
    const char* cA = (const char*)g.A + (size_t)cur.pm * tstepA + (size_t)cur.j * g.a_joff; const char* cB = (const char*)g.Bt + (size_t)cur.pn * tstepB + (size_t)cur.j * g.b_joff;
    PG8_STAGE(PG8_SB(0, 0), cB, B); PG8_STAGE(PG8_SB(0, 1), cB + hstepB, B); PG8_STAGE(PG8_SA(0, 0), cA, A); PG8_STAGE(PG8_SA(0, 1), cA + hstepA, A);
    if (wr == 1) PG8_BAR;
    PG8_WAIT_V(2); PG8_BAR;
    PG8_STAGE(PG8_SB(1, 0), cB + kstep, B); PG8_STAGE(PG8_SA(1, 0), cA + kstep, A); PG8_STAGE(PG8_SB(1, 1), cB + hstepB + kstep, B);
    PG8_WAIT_V(6); PG8_BAR;
    for (;;) {
        const bool has_next = S.next(ui + 1, nxt);
        const char* nA = has_next ? (const char*)g.A + (size_t)nxt.pm * tstepA + (size_t)nxt.j * g.a_joff : cA;
        const char* nB = has_next ? (const char*)g.Bt + (size_t)nxt.pn * tstepB + (size_t)nxt.j * g.b_joff : cB;
        for (int t = 0; t < nt; t += 2) {
            const bool last = (t == nt - 2);
            const char* a1 = cA + (size_t)(t + 1) * kstep;
            const char* a2 = last ? nA : cA + (size_t)(t + 2) * kstep; const char* b2 = last ? nB : cB + (size_t)(t + 2) * kstep;
            const char* a3 = a2 + kstep; const char* b3 = b2 + kstep;
            PG8_LDB(B0, 0, 0); PG8_LDB(B1, 0, 1); PG8_SCHED; PG8_LDA(At, 0, 0); PG8_STAGE(PG8_SA(1, 1), a1 + hstepA, A);
            PG8_WAIT_V(8); PG8_WAIT_L(0); PG8_BAR; PG8_MMA(0, 0, At, B0); PG8_MMA(0, 1, At, B1); PG8_BAR; PG8_SCHED;
            PG8_LDA(At, 0, 1); PG8_STAGE(PG8_SB(0, 0), b2, B); PG8_STAGE(PG8_SB(0, 1), b2 + hstepB, B); PG8_STAGE(PG8_SA(0, 0), a2, A);
            PG8_WAIT_V(8); PG8_WAIT_L(0); PG8_BAR; PG8_MMA(1, 0, At, B0); PG8_MMA(1, 1, At, B1); PG8_BAR; PG8_SCHED;
            PG8_LDB(B0, 1, 0); PG8_LDB(B1, 1, 1); PG8_SCHED; PG8_LDA(At, 1, 0); PG8_STAGE(PG8_SA(0, 1), a2 + hstepA, A);
            PG8_WAIT_V(8); PG8_WAIT_L(0); PG8_BAR; PG8_MMA(0, 0, At, B0); PG8_MMA(0, 1, At, B1); PG8_BAR; PG8_SCHED;
            PG8_LDA(At, 1, 1); PG8_STAGE(PG8_SB(1, 0), b3, B); PG8_STAGE(PG8_SB(1, 1), b3 + hstepB, B); PG8_STAGE(PG8_SA(1, 0), a3, A);
            PG8_WAIT_V(8); PG8_WAIT_L(0); PG8_BAR; PG8_MMA(1, 0, At, B0); PG8_MMA(1, 1, At, B1); PG8_BAR; PG8_SCHED;
        }
        if (wr == 0) PG8_BAR;
        E(acc, cur, wr, wc, fr, fq);
        if (!has_next) break;
        cur = nxt; cA = nA; cB = nB; ++ui;
        if (wr == 1) PG8_BAR;
    }
    PG8_WAIT_V(0);
    PG8_BAR;
#undef PG8_SA
#undef PG8_SB
#undef PG8_STAGE
#undef PG8_LDA
#undef PG8_LDB
#undef PG8_MMA
#undef PG8_WAIT_V
#undef PG8_WAIT_L
#undef PG8_BAR
#undef PG8_SCHED
}
typedef f32x4 Acc[2][2][4][2];
DI void zero_acc(Acc& acc) {
#pragma unroll
    for (int a = 0; a < 2; ++a)
#pragma unroll
        for (int b = 0; b < 2; ++b)
#pragma unroll
            for (int m = 0; m < 4; ++m)
#pragma unroll
                for (int n = 0; n < 2; ++n) acc[a][b][m][n] = (f32x4){0.f, 0.f, 0.f, 0.f};
}

struct EpiG1 {
    bf16_t* Z; bf16_t* R;
    DI void operator()(Acc& acc, const Unit& u, int wr, int wc, int fr, int fq) const {
        const int row0 = u.pm * BM + wr * 64 + fr;
        if (u.pn < NT_SMALL) {
#pragma unroll
            for (int ai = 0; ai < 2; ++ai)
#pragma unroll
                for (int m = 0; m < 4; ++m) { const int row = row0 + ai * HALF + m * 16;
#pragma unroll
                    for (int bj = 0; bj < 2; ++bj) { const int col0 = u.pn * BM + bj * HALF + wc * 32 + 8 * fq; const f32x4 v0 = acc[ai][bj][m][0], v1 = acc[ai][bj][m][1];
                        u32x4 w; w.x = pk2(v0[0], v0[1]); w.y = pk2(v0[2], v0[3]); w.z = pk2(v1[0], v1[1]); w.w = pk2(v1[2], v1[3]);
                        *(u32x4*)(Z + (size_t)row * ZLD + col0) = w; } }
        } else {
            const int d0 = (u.pn - NT_SMALL) * 64 + wc * 16 + fq * 4;
#pragma unroll
            for (int ai = 0; ai < 2; ++ai)
#pragma unroll
                for (int m = 0; m < 4; ++m) { const int row = row0 + ai * HALF + m * 16;
                    float r[4][4];
#pragma unroll
                    for (int e = 0; e < 4; ++e) {
                        const float e0 = __expf(-acc[ai][0][m][0][e]), e1 = __expf(-acc[ai][0][m][1][e]), e2 = __expf(-acc[ai][1][m][0][e]), e3 = __expf(-acc[ai][1][m][1][e]);
                        const float i0 = __builtin_amdgcn_rcpf(1.f + e0), i1 = __builtin_amdgcn_rcpf(1.f + e1), i2 = __builtin_amdgcn_rcpf(1.f + e2), i3 = __builtin_amdgcn_rcpf(1.f + e3);
                        r[0][e] = (1.f + e1) * i0; r[1][e] = (1.f + e2) * i1; r[2][e] = (1.f + e3) * i2; r[3][e] = i3; }
#pragma unroll
                    for (int j = 0; j < 4; ++j) { u32x2 w; w.x = pk2(r[j][0], r[j][1]); w.y = pk2(r[j][2], r[j][3]); *(u32x2*)(R + ((size_t)row * 4 + j) * 1024 + d0) = w; } }
        }
        zero_acc(acc);
    }
};
struct EpiMerge {
    const bf16_t* R; bf16_t* O;
    DI void operator()(Acc& acc, const Unit& u, int wr, int wc, int fr, int fq) const {
        const int row0 = u.pm * BM + wr * 64 + fr;
        u32x4 rr[2][4][2];
#pragma unroll
        for (int ai = 0; ai < 2; ++ai)
#pragma unroll
            for (int m = 0; m < 4; ++m)
#pragma unroll
                for (int bj = 0; bj < 2; ++bj) rr[ai][m][bj] = *(const u32x4*)(R + ((size_t)(row0 + ai * HALF + m * 16) * 4 + u.j) * 1024 + u.pn * BM + bj * HALF + wc * 32 + 8 * fq);
#pragma unroll
        for (int ai = 0; ai < 2; ++ai)
#pragma unroll
            for (int m = 0; m < 4; ++m) { const int row = row0 + ai * HALF + m * 16;
#pragma unroll
                for (int bj = 0; bj < 2; ++bj) { const int col0 = u.pn * BM + bj * HALF + wc * 32 + 8 * fq; const u32x4 q = rr[ai][m][bj];
                    f32x4 v0 = acc[ai][bj][m][0], v1 = acc[ai][bj][m][1];
                    v0[0] *= __uint_as_float(q.x << 16); v0[1] *= __uint_as_float(q.x & 0xffff0000u); v0[2] *= __uint_as_float(q.y << 16); v0[3] *= __uint_as_float(q.y & 0xffff0000u);
                    v1[0] *= __uint_as_float(q.z << 16); v1[1] *= __uint_as_float(q.z & 0xffff0000u); v1[2] *= __uint_as_float(q.w << 16); v1[3] *= __uint_as_float(q.w & 0xffff0000u);
                    if (u.j == 3) { u32x4 w; w.x = pk2(v0[0], v0[1]); w.y = pk2(v0[2], v0[3]); w.z = pk2(v1[0], v1[1]); w.w = pk2(v1[2], v1[3]);
                        *(u32x4*)(O + (size_t)row * 1024 + col0) = w; v0 = (f32x4){0.f, 0.f, 0.f, 0.f}; v1 = v0; }
                    acc[ai][bj][m][0] = v0; acc[ai][bj][m][1] = v1; } }
    }
};
template <int MODE> struct EpiRes {
    float* X; const float* gm; bf16_t* D;
    DI void operator()(Acc& acc, const Unit& u, int wr, int wc, int fr, int fq) const {
        const int row0 = u.pm * BM + wr * 64 + fr;
        const int mr = u.pm < 32 ? 0 : 1 + ((u.pm - 32) >> 2);
        const float* gp = gm + (size_t)mr * 6144;
#pragma unroll
        for (int bj = 0; bj < 2; ++bj) { const int col0 = u.pn * BM + bj * HALF + wc * 32 + 8 * fq;
            const f32x4 g0 = *(const f32x4*)(gp + col0), g1 = *(const f32x4*)(gp + col0 + 4);
#pragma unroll
            for (int ai = 0; ai < 2; ++ai) {
                if (MODE == 1) {
#pragma unroll
                    for (int m = 0; m < 4; ++m) { const int row = row0 + ai * HALF + m * 16; const f32x4 d0 = g0 * acc[ai][bj][m][0], d1 = g1 * acc[ai][bj][m][1];
                        u32x4 w; w.x = pk2(d0[0], d0[1]); w.y = pk2(d0[2], d0[3]); w.z = pk2(d1[0], d1[1]); w.w = pk2(d1[2], d1[3]);
                        *(u32x4*)(D + (size_t)row * 1024 + col0) = w; }
                } else {
                    f32x4 x0[4], x1[4]; u32x4 dd[4];
#pragma unroll
                    for (int m = 0; m < 4; ++m) { const int row = row0 + ai * HALF + m * 16; const float* xp = X + (size_t)row * 1024 + col0;
                        x0[m] = *(const f32x4*)xp; x1[m] = *(const f32x4*)(xp + 4); dd[m] = *(const u32x4*)(D + (size_t)row * 1024 + col0); }
#pragma unroll
                    for (int m = 0; m < 4; ++m) { const int row = row0 + ai * HALF + m * 16; float* xp = X + (size_t)row * 1024 + col0;
                        f32x4 a0 = x0[m] + g0 * acc[ai][bj][m][0], a1 = x1[m] + g1 * acc[ai][bj][m][1]; const u32x4 q = dd[m];
                        a0[0] += __uint_as_float(q.x << 16); a0[1] += __uint_as_float(q.x & 0xffff0000u); a0[2] += __uint_as_float(q.y << 16); a0[3] += __uint_as_float(q.y & 0xffff0000u);
                        a1[0] += __uint_as_float(q.z << 16); a1[1] += __uint_as_float(q.z & 0xffff0000u); a1[2] += __uint_as_float(q.w << 16); a1[3] += __uint_as_float(q.w & 0xffff0000u);
                        *(f32x4*)xp = a0; *(f32x4*)(xp + 4) = a1; }
                }
            }
        }
        zero_acc(acc);
    }
};
struct EpiUG {
    bf16_t* U; bf16_t* G;
    DI void operator()(Acc& acc, const Unit& u, int wr, int wc, int fr, int fq) const {
        const int row0 = u.pm * BM + wr * 64 + fr; const int f0 = u.pn * 128 + wc * 32 + 8 * fq;
#pragma unroll
        for (int ai = 0; ai < 2; ++ai)
#pragma unroll
            for (int m = 0; m < 4; ++m) { const int row = row0 + ai * HALF + m * 16;
#pragma unroll
                for (int bj = 0; bj < 2; ++bj) { const f32x4 v0 = acc[ai][bj][m][0], v1 = acc[ai][bj][m][1];
                    u32x4 w; w.x = pk2(v0[0], v0[1]); w.y = pk2(v0[2], v0[3]); w.z = pk2(v1[0], v1[1]); w.w = pk2(v1[2], v1[3]);
                    *(u32x4*)((bj ? G : U) + (size_t)row * FF + f0) = w; } }
        zero_acc(acc);
    }
};
template <int CTRL> DI float dppf(float oldv, float src) { return __builtin_bit_cast(float, __builtin_amdgcn_update_dpp(__builtin_bit_cast(int, oldv), __builtin_bit_cast(int, src), CTRL, 0xf, 0xf, false)); }
struct EpiConv {
    bf16_t* ACT; const float* cw; const float* cb; float* EX;
    DI void operator()(Acc& acc, const Unit& u, int wr, int wc, int fr, int fq) const {
        int fl_ = wc * 32 + 8 * fq; asm volatile("" : "+v"(fl_));
        const int fl = fl_, f0 = u.pn * 128 + fl;
#pragma unroll
        for (int ai = 0; ai < 2; ++ai) { const int g64 = 2 * ai + wr;
            const bool lo = fr == 0; f32x4 e0, e1;
#pragma unroll
            for (int e = 0; e < 4; ++e) { e0[e] = lo ? acc[ai][0][0][0][e] : acc[ai][0][3][0][e]; e1[e] = lo ? acc[ai][0][0][1][e] : acc[ai][0][3][1][e]; }
            float* ep = EX + (g64 * 2 + (lo ? 0 : 1)) * 128 + fl;
            if (fr == 0 || fr == 15) { *(f32x4*)ep = e0; *(f32x4*)(ep + 4) = e1; } }
        lds_barrier();
#pragma unroll
        for (int n = 0; n < 2; ++n) {
            const f32x4 w0 = *(const f32x4*)(cw + f0 + 4 * n), w1 = *(const f32x4*)(cw + FF + f0 + 4 * n), w2 = *(const f32x4*)(cw + 2 * FF + f0 + 4 * n), bb = *(const f32x4*)(cb + f0 + 4 * n);
#pragma unroll
            for (int ai = 0; ai < 2; ++ai) {
                const int g64 = 2 * ai + wr, gp = g64 > 0 ? g64 - 1 : 0, gn = g64 < 3 ? g64 + 1 : 3;
                const f32x4 hp = *(const f32x4*)(EX + (gp * 2 + 1) * 128 + fl + 4 * n), hn = *(const f32x4*)(EX + (gn * 2 + 0) * 128 + fl + 4 * n);
#pragma unroll
                for (int m = 0; m < 4; ++m) {
                    const int r = ai * HALF + wr * 64 + m * 16 + fr; const int R = u.pm * 254 - 1 + r;
                    const bool valid = (r >= 1) && (r <= 254) && (R < T);
                    const int pos = R < TP ? (R & 255) : ((R - TP) & 1023); const int slen = R < TP ? 256 : 1024;
                    const float lm = pos > 0 ? 1.f : 0.f, rm = pos < slen - 1 ? 1.f : 0.f;
                    float y[4];
#pragma unroll
                    for (int e = 0; e < 4; ++e) {
                        const float uc = acc[ai][0][m][n][e];
                        float oldp, oldn;
                        if (m > 0) oldp = dppf<0x121>(uc, acc[ai][0][m > 0 ? m - 1 : 0][n][e]); else oldp = hp[e];
                        if (m < 3) oldn = dppf<0x12F>(uc, acc[ai][0][m < 3 ? m + 1 : 3][n][e]); else oldn = hn[e];
                        const float up = dppf<0x111>(oldp, uc), un = dppf<0x101>(oldn, uc);
                        const float x = lm * w0[e] * up + w1[e] * uc + rm * w2[e] * un + bb[e];
                        y[e] = gelu_tanh(x) * acc[ai][1][m][n][e]; }
                    if (valid) { u32x2 w; w.x = pk2(y[0], y[1]); w.y = pk2(y[2], y[3]); *(u32x2*)(ACT + (size_t)R * FF + f0 + 4 * n) = w; }
                }
                __builtin_amdgcn_sched_barrier(0);
            }
        }
        zero_acc(acc);
    }
};
struct EpiKvC {
    bf16_t* KD; bf16_t* VT;
    DI void operator()(Acc& acc, const Unit& u, int wr, int wc, int fr, int fq) const {
        const int row0 = u.pm * BM + wr * 64 + fr;
#pragma unroll
        for (int ai = 0; ai < 2; ++ai)
#pragma unroll
            for (int m = 0; m < 4; ++m) { const int row = row0 + ai * HALF + m * 16; const int lb = row >> 9, pos = row & 511;
#pragma unroll
                for (int bj = 0; bj < 2; ++bj) { const int h = u.pn * 2 + bj; const int cc = wc * 32 + 8 * fq; const f32x4 v0 = acc[ai][bj][m][0], v1 = acc[ai][bj][m][1];
                    if (wc < 2) { u32x4 w; w.x = pk2(v0[0], v0[1]); w.y = pk2(v0[2], v0[3]); w.z = pk2(v1[0], v1[1]); w.w = pk2(v1[2], v1[3]);
                        *(u32x4*)(KD + ((size_t)row * 4 + h) * 96 + cc) = w; }
                    else { bf16_t* vp = VT + (((size_t)lb * 4 + h) * 64 + (cc - 64)) * 512 + pos;
#pragma unroll
                        for (int e = 0; e < 4; ++e) { vp[(size_t)e * 512] = f2bf(v0[e]); vp[(size_t)(4 + e) * 512] = f2bf(v1[e]); } } } }
        zero_acc(acc);
    }
};
}

struct ColW1 { const float* w; DI const float* operator()(int p) const {
        if (p < 1280) return w + p; if (p < 2400) return w + p + 32; return nullptr; } };
struct ColGate { const float* w; DI const float* operator()(int p) const {
        const int gt = p >> 8, c = p & 255, bj = c >> 7, wc = (c >> 5) & 3, fq = (c >> 3) & 3, n = (c >> 2) & 1, e = c & 3;
        return w + 2432 + (bj * 2 + n) * 1024 + gt * 64 + wc * 16 + fq * 4 + e; } };
struct ColId { const float* w; DI const float* operator()(int p) const { return w + p; } };
struct ColUG { const float* wu; const float* wg; DI const float* operator()(int p) const { const int t = p >> 8, c = p & 255; return c < 128 ? wu + t * 128 + c : wg + t * 128 + (c - 128); } };

template <class ColFn>
DI void tr_tile(const ColFn& cf, int ldsrc, bf16_t* dst, int lddst, int p0, int k0, float* lds) {
    const int tid = tidx(), i = tid & 63, kk = tid >> 6;
    const float* cp = cf(p0 + i);
#pragma unroll
    for (int it = 0; it < 8; ++it) { const int k = kk * 8 + it; lds[k * 65 + i] = cp ? cp[(size_t)(k0 + k) * ldsrc] : 0.f; }
    __syncthreads();
    const int pp = tid >> 3, kc = tid & 7;
    if (cf(p0 + pp) != nullptr) {
        float v[8];
#pragma unroll
        for (int j = 0; j < 8; ++j) v[j] = lds[(kc * 8 + j) * 65 + pp];
        u32x4 w; w.x = pk2(v[0], v[1]); w.y = pk2(v[2], v[3]); w.z = pk2(v[4], v[5]); w.w = pk2(v[6], v[7]);
        *(u32x4*)(dst + (size_t)(p0 + pp) * lddst + k0 + kc * 8) = w;
    }
    __syncthreads();
}

template <class ColFn>
DI void tr_tile4(const ColFn& cf, int ldsrc, bf16_t* dst, int lddst, int p0, int k0, float* lds) {
    const int tid = tidx(), i = tid & 63, kk = tid >> 6;
    const float* cp = cf(p0 + i);
    float v[32];
#pragma unroll
    for (int it = 0; it < 32; ++it) v[it] = cp ? cp[(size_t)(k0 + kk * 32 + it) * ldsrc] : 0.f;
#pragma unroll
    for (int it = 0; it < 32; ++it) lds[(kk * 32 + it) * 65 + i] = v[it];
    __syncthreads();
    const int pp = tid >> 3, kc = tid & 7;
    if (cf(p0 + pp) != nullptr) {
#pragma unroll
        for (int q = 0; q < 4; ++q) { const int kb = (q * 8 + kc) * 8; float x[8];
#pragma unroll
            for (int j = 0; j < 8; ++j) x[j] = lds[(kb + j) * 65 + pp];
            u32x4 w; w.x = pk2(x[0], x[1]); w.y = pk2(x[2], x[3]); w.z = pk2(x[4], x[5]); w.w = pk2(x[6], x[7]);
            *(u32x4*)(dst + (size_t)(p0 + pp) * lddst + k0 + kb) = w; }
    }
    __syncthreads();
}

DI void modnorm_row(const float* xr, const float* g, const float* sh, const float* sc, bf16_t* out, float* xcopy, int lane) {
    f32x4 v[4]; float ss = 0.f;
#pragma unroll
    for (int i = 0; i < 4; ++i) { v[i] = *(const f32x4*)(xr + i * 256 + lane * 4); ss += v[i][0] * v[i][0] + v[i][1] * v[i][1] + v[i][2] * v[i][2] + v[i][3] * v[i][3]; }
    ss = wave_sum(ss); const float rstd = rsqrtf(ss * (1.f / 1024.f) + EPS);
#pragma unroll
    for (int i = 0; i < 4; ++i) { const int c = i * 256 + lane * 4;
        if (xcopy) *(f32x4*)(xcopy + c) = v[i];
        const f32x4 gg = *(const f32x4*)(g + c), s1 = *(const f32x4*)(sc + c), s0 = *(const f32x4*)(sh + c);
        f32x4 y = v[i] * rstd * gg * (s1 + 1.f) + s0;
        u32x2 w; w.x = pk2(y[0], y[1]); w.y = pk2(y[2], y[3]); *(u32x2*)(out + c) = w; }
}
DI int modrow_of(int t) { return t < TP ? 0 : 1 + ((t - TP) >> 10); }

DI void p0_mod_item(const Params& P, int it, float* lds) {
    const int tid = tidx(), l = it / 96, n = (it % 96) * 64 + (tid & 63), kg = tid >> 6;
    float* sv = lds;
    float* red = lds + 9 * 1024;
    for (int idx = tid; idx < 9 * 1024; idx += 512) { const int r = idx >> 10, k = idx & 1023; const float c = r == 0 ? P.in[11][k] : P.in[2][(r - 1) * 1024 + k]; sv[idx] = siluf_(c); }
    __syncthreads();
    float acc[9];
#pragma unroll
    for (int r = 0; r < 9; ++r) acc[r] = 0.f;
    const float* wp = P.in[12] + ((size_t)l * 1024 + kg * 128) * 6144 + n;
    for (int k = 0; k < 128; ++k) { const float w = wp[(size_t)k * 6144];
#pragma unroll
        for (int r = 0; r < 9; ++r) acc[r] += sv[r * 1024 + kg * 128 + k] * w; }
#pragma unroll
    for (int r = 0; r < 9; ++r) red[(kg * 9 + r) * 64 + (tid & 63)] = acc[r];
    __syncthreads();
    float* MOD = (float*)(P.ws + WS_MOD);
    for (int idx = tid; idx < 576; idx += 512) { const int r = idx >> 6, c = idx & 63; float s = 0.f;
#pragma unroll
        for (int q = 0; q < 8; ++q) s += red[(q * 9 + r) * 64 + c];
        const int nn = (it % 96) * 64 + c; MOD[((size_t)l * 9 + r) * 6144 + nn] = s + P.in[13][l * 6144 + nn]; }
    __syncthreads();
}
DI void p0_wc_item(const Params& P, int it, float* lds) {
    const int tid = tidx(), l = it >> 5, k0 = (it & 31) * 32;
    float* src = lds;
    const float* win = P.in[16] + (size_t)l * 1024 * WIN;
    for (int idx = tid; idx < 32 * 224; idx += 512) { const int k = idx / 224, c = idx % 224; float v;
        if (c < 32) v = win[(size_t)(k0 + k) * WIN + 1280 + c];
        else v = win[(size_t)(k0 + k) * WIN + 2080 + (c - 32)] * P.in[29][l * 192 + (c - 32)];
        src[k * 352 + c] = v; }
    __syncthreads();
    bf16_t* WCT = (bf16_t*)(P.ws + WS_WCT);
    for (int n = tid; n < NWC; n += 512) {
        int sc, R, ldu; const float* wu;
        if (n < 128) { sc = 0; R = 16; ldu = 128; wu = P.in[19] + (size_t)l * 16 * 128 + n; }
        else if (n < 256) { sc = 16; R = 16; ldu = 128; wu = P.in[21] + (size_t)l * 16 * 128 + (n - 128); }
        else { sc = 32; R = 192; ldu = 384; wu = P.in[30] + (size_t)l * 192 * 384 + (n - 256); }
        float acc[32];
#pragma unroll
        for (int k = 0; k < 32; ++k) acc[k] = 0.f;
        for (int r = 0; r < R; ++r) { const float w = wu[(size_t)r * ldu];
#pragma unroll
            for (int k = 0; k < 32; ++k) acc[k] += src[k * 352 + sc + r] * w; }
        bf16_t* op = WCT + ((size_t)l * NWC + n) * 1024 + k0;
#pragma unroll
        for (int q = 0; q < 4; ++q) { u32x4 w; w.x = pk2(acc[q * 8], acc[q * 8 + 1]); w.y = pk2(acc[q * 8 + 2], acc[q * 8 + 3]); w.z = pk2(acc[q * 8 + 4], acc[q * 8 + 5]); w.w = pk2(acc[q * 8 + 6], acc[q * 8 + 7]);
            *(u32x4*)(op + q * 8) = w; }
    }
    __syncthreads();
}
constexpr int VT_LD = 66;
DI void vt_flush(const bf16_t* vt, int row_lo, int row_hi, bf16_t* dst_base, int rows_per_head_stride_unused, size_t ldv, int pos0) {
    const int n = (row_hi - row_lo) * 32;
    for (int idx = tidx(); idx < n; idx += 512) { const int r = idx >> 5, c = idx & 31;
        const unsigned v = *(const unsigned*)(vt + (size_t)(row_lo + r) * VT_LD + 2 * c);
        *(unsigned*)(dst_base + (size_t)r * ldv + pos0 + 2 * c) = v; }
}
DI void p0_cache_item(const Params& P, int it, bf16_t* vt) {
    const int tid = tidx(), lane = tid & 63, w = tid >> 6;
    const int b = it >> 5, l = (it >> 3) & 3, pt = it & 7, lb = l * 8 + b, pos0 = pt * 64;
    bf16_t* KAC = (bf16_t*)(P.ws + WS_KAC); bf16_t* KCC = (bf16_t*)(P.ws + WS_KCC); bf16_t* KDC = (bf16_t*)(P.ws + WS_KDC); bf16_t* CKVB = (bf16_t*)(P.ws + WS_CKVB);
    for (int i = w; i < 64; i += 8) { const int pos = pos0 + i; const size_t rb = ((size_t)(b * 4 + l) * 512 + pos);
#pragma unroll
        for (int g = 0; g < 2; ++g) { KAC[((size_t)lb * 512 + pos) * 128 + g * 64 + lane] = f2bf(P.in[3][rb * 128 + g * 64 + lane]);
            vt[(g * 64 + lane) * VT_LD + i] = f2bf(P.in[4][rb * 128 + g * 64 + lane]);
            CKVB[((size_t)lb * 512 + pos) * 128 + g * 64 + lane] = f2bf(P.in[9][rb * 128 + g * 64 + lane]); }
#pragma unroll
        for (int g = 0; g < 4; ++g) { KCC[((size_t)lb * 512 + pos) * 256 + g * 64 + lane] = f2bf(P.in[7][rb * 256 + g * 64 + lane]);
            vt[(128 + g * 64 + lane) * VT_LD + i] = f2bf(P.in[8][rb * 256 + g * 64 + lane]); }
        if (lane < 32) { const bf16_t kr = f2bf(P.in[10][rb * 32 + lane]);
#pragma unroll
            for (int h = 0; h < 4; ++h) KDC[(((size_t)lb * 512 + pos) * 4 + h) * 96 + 64 + lane] = kr; }
    }
    __syncthreads();
    vt_flush(vt, 0, 128, (bf16_t*)(P.ws + WS_VAC) + (size_t)lb * 128 * 512, 0, 512, pos0);
    vt_flush(vt, 128, 384, (bf16_t*)(P.ws + WS_VCC) + (size_t)lb * 256 * 512, 0, 512, pos0);
    __syncthreads();
}
DI void p0_tables(const Params& P) {
    float* TAB = (float*)(P.ws + WS_TAB);
    const int tid = tidx();
    for (int idx = tid; idx < 1024; idx += 512) { const int pos = idx >> 4, i = idx & 15; const float inv = powf(10000.f, -(float)i / 16.f); const float a = (float)pos * inv; TAB[idx * 2] = cosf(a); TAB[idx * 2 + 1] = sinf(a); }
    for (int idx = tid; idx < 512; idx += 512) { const int pos = idx >> 3, i = idx & 7; const float inv = powf(10000.f, -(float)i / 8.f); const float a = (float)pos * inv; TAB[2048 + idx * 2] = cosf(a); TAB[2048 + idx * 2 + 1] = sinf(a); }
    if (tid < 4) { const int l = tid; float s1 = 0.f, s2 = 0.f;
        for (int i = 0; i < 32; ++i) { s1 += P.in[24][l * 32 + i] * P.in[25][l * 32 + i]; s2 += P.in[26][l * 32 + i] * P.in[27][l * 32 + i]; }
        const float li = 0.8f - 0.6f * expf(-0.3f * (float)l);
        TAB[3072 + l] = expf(s1) - expf(s2) + li; TAB[3076 + l] = li; }
}
DI void phase0(const Params& P, unsigned char* lds) {
    const int NMOD = 384, NWC = 128, NCACHE = 256, NTAB = 1, NTR = 64;
    for (int it = blockIdx.x; it < NMOD + NWC + NCACHE + NTAB + NTR; it += gridDim.x) {
        int j = it;
        if (j < NWC) { p0_wc_item(P, j, (float*)lds); continue; } j -= NWC;
        if (j < NMOD) { p0_mod_item(P, j, (float*)lds); continue; } j -= NMOD;
        if (j < NCACHE) { p0_cache_item(P, j, (bf16_t*)lds); continue; } j -= NCACHE;
        if (j < NTAB) { p0_tables(P); continue; } j -= NTAB;
        { const int l = j >> 4, r = j & 15, pt = r >> 1, kt = r & 1; ColId cf{P.in[32] + (size_t)l * 128 * 512};
          tr_tile(cf, 512, (bf16_t*)(P.ws + WS_WUKVT) + (size_t)l * 512 * 128, 128, pt * 64, kt * 64, (float*)lds); }
    }
}

#define NORM_ITEMS_LOOP(call) do { if (gridDim.x == 256) { const int c_ = blockIdx.x; _Pragma("unroll 1") for (int k_ = 0; k_ < 2; ++k_) { const int it = 64 * (c_ & 7) + (c_ >> 3) + 32 * k_; call; } } \
    else { for (int it = blockIdx.x; it < 512; it += gridDim.x) { call; } } } while (0)
DI void norm_rows_items(const Params& P, int l, int which  , int it) {
    const int tid = tidx(), lane = tid & 63, w = tid >> 6, tb = it * 32 + w;
    const float* MOD = (const float*)(P.ws + WS_MOD);
    float* X = P.out;
    const bool from_in = (which == 0 && l == 0);
    const float* src = from_in ? (tb < TP ? P.in[0] + (size_t)tb * 1024 : P.in[1] + (size_t)(tb - TP) * 1024) : X + (size_t)tb * 1024;
    f32x4 v[4][4]; float ss[4];
#pragma unroll
    for (int r = 0; r < 4; ++r)
#pragma unroll
        for (int i = 0; i < 4; ++i) v[r][i] = *(const f32x4*)(src + (size_t)r * 8 * 1024 + i * 256 + lane * 4);
    if (which == 1) {
        const bf16_t* dp = (const bf16_t*)(P.ws + WS_Z) + (size_t)tb * 1024;
#pragma unroll
        for (int r = 0; r < 4; ++r)
#pragma unroll
            for (int i = 0; i < 4; ++i) { const u32x2 d = *(const u32x2*)(dp + (size_t)r * 8 * 1024 + i * 256 + lane * 4);
                v[r][i][0] += __uint_as_float(d.x << 16); v[r][i][1] += __uint_as_float(d.x & 0xffff0000u); v[r][i][2] += __uint_as_float(d.y << 16); v[r][i][3] += __uint_as_float(d.y & 0xffff0000u); }
    }
#pragma unroll
    for (int r = 0; r < 4; ++r) { float q = 0.f;
#pragma unroll
        for (int i = 0; i < 4; ++i) q += v[r][i][0] * v[r][i][0] + v[r][i][1] * v[r][i][1] + v[r][i][2] * v[r][i][2] + v[r][i][3] * v[r][i][3];
        ss[r] = q; }
#pragma unroll
    for (int o = 1; o < 64; o <<= 1) {
#pragma unroll
        for (int r = 0; r < 4; ++r) ss[r] += __shfl_xor(ss[r], o); }
    if (which == 2) {
#pragma unroll
        for (int i = 0; i < 4; ++i) { const int c = i * 256 + lane * 4; const f32x4 gg = *(const f32x4*)(P.in[40] + c);
#pragma unroll
            for (int r = 0; r < 4; ++r) *(f32x4*)(X + (size_t)(tb + 8 * r) * 1024 + c) = v[r][i] * rsqrtf(ss[r] * (1.f / 1024.f) + EPS) * gg; }
        return;
    }
    const float* mp = MOD + ((size_t)l * 9 + modrow_of(tb)) * 6144 + (which ? 3072 : 0);
    const float* g = (which ? P.in[15] : P.in[14]) + l * 1024;
    bf16_t* out = (bf16_t*)(P.ws + WS_HB) + (size_t)tb * 1024;
#pragma unroll
    for (int i = 0; i < 4; ++i) { const int c = i * 256 + lane * 4;
        const f32x4 gg = *(const f32x4*)(g + c), s1 = *(const f32x4*)(mp + 1024 + c), s0 = *(const f32x4*)(mp + c); const f32x4 gs = gg * (s1 + 1.f);
#pragma unroll
        for (int r = 0; r < 4; ++r) {
            if (from_in) *(f32x4*)(X + (size_t)(tb + 8 * r) * 1024 + c) = v[r][i];
            const f32x4 y = v[r][i] * rsqrtf(ss[r] * (1.f / 1024.f) + EPS) * gs + s0;
            u32x2 wv; wv.x = pk2(y[0], y[1]); wv.y = pk2(y[2], y[3]); *(u32x2*)(out + (size_t)r * 8 * 1024 + c) = wv; } }
}
DI void conv_items(const Params& P, int l, int group, int first, int stride, unsigned char* lds) {
    const int N_W1A = 152, N_W1G = 256, N_CP = 84, N_BR = 64, N_OUT = 64, N_UG = 352, N_FD = 176;
    bf16_t* W1 = (bf16_t*)(P.ws + WS_W1);
    if (group == 0) {
        for (int it = first; it < N_W1A + N_W1G + N_CP; it += stride) {
            int j = it;
            if (j < N_W1A) { ColW1 cf{P.in[16] + (size_t)l * 1024 * WIN}; tr_tile4(cf, WIN, W1, 1024, (j >> 2) * 64, (j & 3) * 256, (float*)lds); continue; } j -= N_W1A;
            if (j < N_W1G) { ColGate cf{P.in[16] + (size_t)l * 1024 * WIN}; tr_tile4(cf, WIN, W1 + (size_t)ZLD * 1024, 1024, (j >> 2) * 64, (j & 3) * 256, (float*)lds); continue; } j -= N_W1G;
            {
                const int r0 = j * 8; const int tid = tidx();
                for (int idx = tid; idx < 8 * 128; idx += 512) { const int r = r0 + (idx >> 7), c = (idx & 127) * 8;
                    u32x4 v = (u32x4){0u, 0u, 0u, 0u};
                    if (r < NWC) v = *(const u32x4*)((const bf16_t*)(P.ws + WS_WCT) + ((size_t)l * NWC + r) * 1024 + c);
                    *(u32x4*)(W1 + (size_t)(2400 + r) * 1024 + c) = v; } }
        }
    } else {
        for (int it = first; it < N_BR + N_OUT + N_UG + N_FD; it += stride) {
            int j = it;
            if (j < N_BR) { const int br = j >> 4, r = j & 15; ColId cf{P.in[33] + ((size_t)l * 4 + br) * 256 * 1024};
                tr_tile4(cf, 1024, (bf16_t*)(P.ws + WS_WBR) + (size_t)br * 1024 * 256, 256, r * 64, 0, (float*)lds); continue; } j -= N_BR;
            if (j < N_OUT) { ColId cf{P.in[34] + (size_t)l * 1024 * 1024}; tr_tile4(cf, 1024, (bf16_t*)(P.ws + WS_WOUT), 1024, (j >> 2) * 64, (j & 3) * 256, (float*)lds); continue; } j -= N_OUT;
            if (j < N_UG) { ColUG cf{P.in[35] + (size_t)l * 1024 * FF, P.in[36] + (size_t)l * 1024 * FF}; tr_tile4(cf, FF, (bf16_t*)(P.ws + WS_WUG), 1024, (j >> 2) * 64, (j & 3) * 256, (float*)lds); continue; } j -= N_UG;
            { ColId cf{P.in[39] + (size_t)l * FF * 1024}; tr_tile4(cf, 1024, (bf16_t*)(P.ws + WS_WFD), FF, (j / 11) * 64, (j % 11) * 256, (float*)lds); }
        }
    }
}
DI void idle_slice(int nwg, int& first, int& stride) {
    const int G = gridDim.x, rem = nwg % G, c = blockIdx.x;
    if (rem == 0) { first = c; stride = G; } else if (c >= rem) { first = c - rem; stride = G - rem; } else { first = 1 << 30; stride = 1; }
}
DI void phaseA(const Params& P, int l, unsigned char* lds) {
    if (l == 0) {
        pg8::Gemm g{(const bf16_t*)(P.ws + WS_CKVB), (const bf16_t*)(P.ws + WS_WUKVT), 128, 128, 128, 0, (size_t)512 * 128 * 2};
        pg8::StaticOrder S; S.init(T, 512, gridDim.x, blockIdx.x, 2);
        pg8::EpiKvC E{(bf16_t*)(P.ws + WS_KDC), (bf16_t*)(P.ws + WS_VDC)};
        pg8::gemm_phase(( LAS unsigned char*)lds, g, S, E);
        __syncthreads();
    }
    if (l == 0) conv_items(P, 0, 0, blockIdx.x, gridDim.x, lds);
    NORM_ITEMS_LOOP(norm_rows_items(P, l, 0, it));
}

DI float rope_lane(float v, int e, int style, int prow, int pcol, const float* TAB) {
    if (style == 0) { const float pv = __shfl_xor(v, 16); const int i = e & 31; const int pos = (e & 32) ? pcol : prow; const float* cs = TAB + (pos * 16 + (i & 15)) * 2;
        return (i & 16) ? v * cs[0] + pv * cs[1] : v * cs[0] - pv * cs[1]; }
    else { const float pv = __shfl_xor(v, 8); const int i = e & 31; const int pos = (i & 16) ? pcol : prow; const float* cs = TAB + 2048 + (pos * 8 + (i & 7)) * 2;
        return (i & 8) ? v * cs[0] + pv * cs[1] : v * cs[0] - pv * cs[1]; }
}
DI void phaseP2(const Params& P, int l, unsigned char* lds) {
    const int tid = tidx(), lane = tid & 63, w = tid >> 6;
    bf16_t* vt = (bf16_t*)lds;
    bf16_t* AK = (bf16_t*)(lds + 640 * VT_LD * 2);
    const bf16_t* Z = (const bf16_t*)(P.ws + WS_Z);
    const float* TAB = (const float*)(P.ws + WS_TAB);
    bf16_t* QA = (bf16_t*)(P.ws + WS_QA); bf16_t* KAN = (bf16_t*)(P.ws + WS_KAN); bf16_t* QC = (bf16_t*)(P.ws + WS_QC); bf16_t* KCN = (bf16_t*)(P.ws + WS_KCN);
    bf16_t* QD = (bf16_t*)(P.ws + WS_QD); bf16_t* KDN = (bf16_t*)(P.ws + WS_KDN);
    const float scA = 0.125f * LOG2E, scC = 0.17677669529663687f * LOG2E, scD = 0.10206207261596575f * LOG2E;
    for (int it = blockIdx.x; it < 256; it += gridDim.x) {
        const int t0 = it * 64; const bool smp = t0 >= TP;
        const int seqlen = smp ? 1024 : 256; const int pos0 = smp ? ((t0 - TP) & 1023) : (t0 & 255); const int bq = smp ? ((t0 - TP) >> 10) : (t0 >> 8);
        const int L = lane, hl = L & 15, l7 = L & 7;
        bf16x8 wfr[4][4];
        { const bf16_t* Wt = (const bf16_t*)(P.ws + WS_WUKVT) + (size_t)l * 512 * 128 + (size_t)((w >> 1) * 128 + (w & 1) * 64) * 128;
#pragma unroll
          for (int nt = 0; nt < 4; ++nt)
#pragma unroll
              for (int ks = 0; ks < 4; ++ks) wfr[nt][ks] = *(const bf16x8*)(Wt + (size_t)(nt * 16 + (lane & 15)) * 128 + ks * 32 + (lane >> 4) * 8); }
        for (int i = w; i < 64; i += 8) {
            const int t = t0 + i, pos = pos0 + i; const int prow = pos >> 6, pcol = pos & 63;
            const bf16_t* zr = Z + (size_t)t * ZLD + 4 * L;
            const size_t orow = ((size_t)(bq * 4 + l) * 256 + pos);
            u32x2 raw[9];
            { const int cb[9] = {0, 256, 1280, 1536, 1792, 2048, 2304, 2560, 2816};
#pragma unroll
              for (int q = 0; q < 9; ++q) raw[q] = *(const u32x2*)(zr + cb[q]); }
            auto un4 = [&](const u32x2 r, float* o) { o[0] = __uint_as_float(r.x << 16); o[1] = __uint_as_float(r.x & 0xffff0000u); o[2] = __uint_as_float(r.y << 16); o[3] = __uint_as_float(r.y & 0xffff0000u); };
            auto pk4 = [&](const float* o) { u32x2 r; r.x = pk2(o[0], o[1]); r.y = pk2(o[2], o[3]); return r; };
            auto red16 = [&](float x) { x += __shfl_xor(x, 1); x += __shfl_xor(x, 2); x += __shfl_xor(x, 4); x += __shfl_xor(x, 8); return x; };
            auto ropeA = [&](float* v) {
                const int pp = (hl & 8) ? pcol : prow; const bool hi = hl & 4;
#pragma unroll
                for (int j = 0; j < 4; ++j) { const float pv = __shfl_xor(v[j], 4); const float* cs = TAB + (pp * 16 + 4 * (hl & 3) + j) * 2; v[j] = hi ? v[j] * cs[0] + pv * cs[1] : v[j] * cs[0] - pv * cs[1]; } };
            auto ropeC = [&](float* v) {
                const int pp = (l7 & 4) ? pcol : prow; const bool hi = l7 & 2;
#pragma unroll
                for (int j = 0; j < 4; ++j) { const float pv = __shfl_xor(v[j], 2); const float* cs = TAB + 2048 + (pp * 8 + 4 * (l7 & 1) + j) * 2; v[j] = hi ? v[j] * cs[0] + pv * cs[1] : v[j] * cs[0] - pv * cs[1]; } };
            float v[4], u4[4];
            { un4(raw[0], v); const float ss = red16(v[0] * v[0] + v[1] * v[1] + v[2] * v[2] + v[3] * v[3]); const float rs = rsqrtf(ss * (1.f / 64.f) + EPS);
              const f32x4 g = *(const f32x4*)(P.in[17] + l * 64 + 4 * hl);
#pragma unroll
              for (int j = 0; j < 4; ++j) v[j] *= rs * g[j];
              if (smp) ropeA(v);
#pragma unroll
              for (int j = 0; j < 4; ++j) v[j] *= scA;
              *(u32x2*)(QA + (size_t)t * 256 + 4 * L) = pk4(v); }
            { un4(raw[1], v); const float ss = red16(v[0] * v[0] + v[1] * v[1] + v[2] * v[2] + v[3] * v[3]); const float rs = rsqrtf(ss * (1.f / 64.f) + EPS);
              const f32x4 g = *(const f32x4*)(P.in[18] + l * 64 + 4 * hl);
#pragma unroll
              for (int j = 0; j < 4; ++j) u4[j] = v[j] * rs * g[j];
              if (smp) ropeA(u4);
              if (L < 32) { *(u32x2*)(KAN + (size_t)t * 128 + 4 * L) = pk4(u4); if (!smp) *(f32x4*)(P.out + O_AK + orow * 128 + 4 * L) = (f32x4){u4[0], u4[1], u4[2], u4[3]}; }
              else {
#pragma unroll
                  for (int j = 0; j < 4; ++j) vt[(4 * (L - 32) + j) * VT_LD + i] = f2bf(v[j]);
                  if (!smp) *(f32x4*)(P.out + O_AV + orow * 128 + 4 * (L - 32)) = (f32x4){v[0], v[1], v[2], v[3]}; } }
            { un4(raw[2], v); if (smp) ropeC(v);
#pragma unroll
              for (int j = 0; j < 4; ++j) v[j] *= scC;
              *(u32x2*)(QC + (size_t)t * 256 + 4 * L) = pk4(v);
              un4(raw[3], v); if (smp) ropeC(v);
              *(u32x2*)(KCN + (size_t)t * 256 + 4 * L) = pk4(v);
              if (!smp) *(f32x4*)(P.out + O_CK + orow * 256 + 4 * L) = (f32x4){v[0], v[1], v[2], v[3]};
              un4(raw[4], v);
#pragma unroll
              for (int j = 0; j < 4; ++j) vt[(128 + 4 * L + j) * VT_LD + i] = f2bf(v[j]);
              if (!smp) *(f32x4*)(P.out + O_CV + orow * 256 + 4 * L) = (f32x4){v[0], v[1], v[2], v[3]}; }
            float b8[4], b9[4];
            un4(raw[5], b8); un4(raw[6], b9);
            const float s8 = b8[0] * b8[0] + b8[1] * b8[1] + b8[2] * b8[2] + b8[3] * b8[3], s9 = b9[0] * b9[0] + b9[1] * b9[1] + b9[2] * b9[2] + b9[3] * b9[3];
            const float rq = rsqrtf(wave_sum(L < 48 ? s8 : 0.f) * (1.f / 192.f) + EPS);
            const float rk = rsqrtf(wave_sum((L >= 48 ? s8 : 0.f) + (L < 16 ? s9 : 0.f)) * (1.f / 128.f) + EPS);
            if (L >= 48 || L < 16) {
                const int m = L >= 48 ? 4 * (L - 48) : 64 + 4 * L; const f32x4 g = *(const f32x4*)(P.in[31] + l * 128 + m);
                float c4[4];
#pragma unroll
                for (int j = 0; j < 4; ++j) c4[j] = (L >= 48 ? b8[j] : b9[j]) * rk * g[j];
                if (!smp) *(f32x4*)(P.out + O_DCKV + orow * 128 + m) = (f32x4){c4[0], c4[1], c4[2], c4[3]};
                *(u32x2*)(AK + i * 136 + m) = pk4(c4); }
            {
              if (smp) ropeC(b9);
              if (L >= 16 && L < 24) { const int i0 = 4 * (L - 16);
                  if (!smp) *(f32x4*)(P.out + O_DKR + orow * 32 + i0) = (f32x4){b9[0], b9[1], b9[2], b9[3]};
                  const u32x2 kb = pk4(b9);
#pragma unroll
                  for (int h = 0; h < 4; ++h) *(u32x2*)(KDN + ((size_t)t * 4 + h) * 96 + 64 + i0) = kb; } }
            { un4(raw[7], v);
#pragma unroll
              for (int j = 0; j < 4; ++j) v[j] *= rq;
              { float rv[4] = {v[0], v[1], v[2], v[3]}; if (smp) ropeC(rv); const int w0 = (4 * L) % 96; if (smp && w0 >= 64) { v[0] = rv[0]; v[1] = rv[1]; v[2] = rv[2]; v[3] = rv[3]; } }
#pragma unroll
              for (int j = 0; j < 4; ++j) v[j] *= scD;
              if (L >= 24) *(u32x2*)(QD + (size_t)t * 384 + 4 * L - 96) = pk4(v); }
            { un4(raw[8], v);
#pragma unroll
              for (int j = 0; j < 4; ++j) v[j] *= rq;
              { float rv[4] = {v[0], v[1], v[2], v[3]}; if (smp) ropeC(rv); const int w0 = (64 + 4 * L) % 96; if (smp && w0 >= 64) { v[0] = rv[0]; v[1] = rv[1]; v[2] = rv[2]; v[3] = rv[3]; } }
#pragma unroll
              for (int j = 0; j < 4; ++j) v[j] *= scD;
              if (L < 56) *(u32x2*)(QD + (size_t)t * 384 + 160 + 4 * L) = pk4(v); }
        }
        __syncthreads();
        {
            const int h = w >> 1, half = w & 1, fr = lane & 15, fq = lane >> 4;
#pragma unroll
            for (int nt = 0; nt < 4; ++nt) {
#pragma unroll
                for (int tt = 0; tt < 4; ++tt) {
                    f32x4 acc = (f32x4){0.f, 0.f, 0.f, 0.f};
#pragma unroll
                    for (int ks = 0; ks < 4; ++ks) { const bf16x8 a = *(const bf16x8*)(AK + (tt * 16 + fr) * 136 + ks * 32 + fq * 8); acc = MFMA16(wfr[nt][ks], a, acc); }
                    const int tl = tt * 16 + fr;
                    if (half == 0) { u32x2 o2; o2.x = pk2(acc[0], acc[1]); o2.y = pk2(acc[2], acc[3]); *(u32x2*)(KDN + ((size_t)(t0 + tl) * 4 + h) * 96 + nt * 16 + fq * 4) = o2; }
                    else {
#pragma unroll
                        for (int j = 0; j < 4; ++j) vt[(384 + h * 64 + nt * 16 + fq * 4 + j) * VT_LD + tl] = f2bf(acc[j]); }
                }
            }
        }
        __syncthreads();
        {
            const size_t ldv = seqlen;
            bf16_t* va = (bf16_t*)(P.ws + WS_VAN) + (smp ? (size_t)32 * 128 * 256 + (size_t)bq * 128 * 1024 : (size_t)bq * 128 * 256);
            bf16_t* vc = (bf16_t*)(P.ws + WS_VCN) + (smp ? (size_t)32 * 256 * 256 + (size_t)bq * 256 * 1024 : (size_t)bq * 256 * 256);
            bf16_t* vd = (bf16_t*)(P.ws + WS_VDN) + (smp ? (size_t)32 * 256 * 256 + (size_t)bq * 256 * 1024 : (size_t)bq * 256 * 256);
            vt_flush(vt, 0, 128, va, 0, ldv, pos0); vt_flush(vt, 128, 384, vc, 0, ldv, pos0); vt_flush(vt, 384, 640, vd, 0, ldv, pos0);
        }
        __syncthreads();
    }
}

#define MFMA32(a, b, c) __builtin_amdgcn_mfma_f32_32x32x16_bf16((a), (b), (c), 0, 0, 0)
struct KSeg { const bf16_t* K; const bf16_t* Vt; int ldk, ldv, len; };
struct AttnOut { bf16_t* O; float lam, oscale; const float* g; };

template <int DKROW, int DK, int NMAP>
DI void attn_wave(const bf16_t* Q, int ldq, int mapoff, const KSeg s0, const KSeg s1, const AttnOut ao, int lane, unsigned char* lds) {
    constexpr int NS = DK / 16, KLD = DKROW + 8, VLD = 72, KBUF = 64 * KLD * 2, VBUF = 64 * VLD * 2, CPR = DKROW / 8, NCH = 64 * CPR;
    const int tid = tidx();
    const int r = lane & 31, h = lane >> 5;
    bf16x8 qf[NMAP][NS];
#pragma unroll
    for (int mp = 0; mp < NMAP; ++mp)
#pragma unroll
        for (int s = 0; s < NS; ++s) qf[mp][s] = *(const bf16x8*)(Q + (size_t)r * ldq + mp * mapoff + s * 16 + h * 8);
    f32x16 O[NMAP][2]; float mrun[NMAP], lrun[NMAP];
#pragma unroll
    for (int mp = 0; mp < NMAP; ++mp) { mrun[mp] = -1e30f; lrun[mp] = 0.f;
#pragma unroll
        for (int d = 0; d < 2; ++d)
#pragma unroll
            for (int i = 0; i < 16; ++i) O[mp][d][i] = 0.f; }
    const int nt0 = s0.len >> 6, ntiles = nt0 + (s1.len >> 6);
    const int krow0 = tid / CPR, kch0 = tid % CPR, krow1 = (tid + 512) / CPR, kch1 = (tid + 512) % CPR, vrow = tid >> 3, vch = tid & 7;
    struct Stg { u32x4 k0, k1, v; };
    Stg RA_, RB_;
    auto gload = [&](int ti, Stg& R) {
        const bool first = ti < nt0; const KSeg& sg = first ? s0 : s1; const int kb = (first ? ti : ti - nt0) * 64;
        R.k0 = *(const u32x4*)(sg.K + (size_t)(kb + krow0) * sg.ldk + kch0 * 8);
        if (NCH > 512) { if (tid + 512 < NCH) R.k1 = *(const u32x4*)(sg.K + (size_t)(kb + krow1) * sg.ldk + kch1 * 8); }
        R.v = *(const u32x4*)(sg.Vt + (size_t)vrow * sg.ldv + kb + vch * 8);
    };
    auto sstore = [&](int b, const Stg& R) {
        unsigned char* kb_ = lds + b * (KBUF + VBUF); unsigned char* vb_ = kb_ + KBUF;
        *(u32x4*)(kb_ + (krow0 * KLD + kch0 * 8) * 2) = R.k0;
        if (NCH > 512) { if (tid + 512 < NCH) *(u32x4*)(kb_ + (krow1 * KLD + kch1 * 8) * 2) = R.k1; }
        *(u32x4*)(vb_ + (vrow * VLD + vch * 8) * 2) = R.v;
    };
    auto compute = [&](int bsel) __attribute__((always_inline)) {
        const unsigned char* kbuf = lds + bsel * (KBUF + VBUF); const unsigned char* vbuf = kbuf + KBUF;
        if constexpr (NMAP == 1) {
            f32x16 S0, S1;
#pragma unroll
            for (int i = 0; i < 16; ++i) { S0[i] = 0.f; S1[i] = 0.f; }
#pragma unroll
            for (int s = 0; s < NS; ++s) { const bf16x8 k0 = *(const bf16x8*)(kbuf + (r * KLD + s * 16 + h * 8) * 2); S0 = MFMA32(k0, qf[0][s], S0); }
#pragma unroll
            for (int s = 0; s < NS; ++s) { const bf16x8 k1 = *(const bf16x8*)(kbuf + ((32 + r) * KLD + s * 16 + h * 8) * 2); S1 = MFMA32(k1, qf[0][s], S1); }
            float mx = fmaxf(S0[0], S1[0]);
#pragma unroll
            for (int i = 1; i < 16; ++i) mx = fmaxf(mx, fmaxf(S0[i], S1[i]));
            if (!__all(mx - mrun[0] <= 8.f)) {
                const float mp = fmaxf(mx, __shfl_xor(mx, 32));
                const float mnew = fmaxf(mrun[0], mp); const float alpha = __builtin_amdgcn_exp2f(mrun[0] - mnew); mrun[0] = mnew;
                lrun[0] *= alpha;
#pragma unroll
                for (int d = 0; d < 2; ++d)
#pragma unroll
                    for (int i = 0; i < 16; ++i) O[0][d][i] *= alpha;
            }
            const float mcur = mrun[0];
            float ps = 0.f;
#pragma unroll
            for (int i = 0; i < 16; ++i) { S0[i] = __builtin_amdgcn_exp2f(S0[i] - mcur); S1[i] = __builtin_amdgcn_exp2f(S1[i] - mcur); ps += S0[i] + S1[i]; }
            lrun[0] += ps;
#pragma unroll
            for (int ks = 0; ks < 4; ++ks) { const int s8 = 8 * (ks & 1);
                u32x4 pw;
                if (ks < 2) { pw.x = pk2(S0[s8], S0[s8 + 1]); pw.y = pk2(S0[s8 + 2], S0[s8 + 3]); pw.z = pk2(S0[s8 + 4], S0[s8 + 5]); pw.w = pk2(S0[s8 + 6], S0[s8 + 7]); }
                else { pw.x = pk2(S1[s8], S1[s8 + 1]); pw.y = pk2(S1[s8 + 2], S1[s8 + 3]); pw.z = pk2(S1[s8 + 4], S1[s8 + 5]); pw.w = pk2(S1[s8 + 6], S1[s8 + 7]); }
                const bf16x8 pf = __builtin_bit_cast(bf16x8, pw);
#pragma unroll
                for (int d = 0; d < 2; ++d) { const unsigned char* vp = vbuf + ((d * 32 + r) * VLD + 16 * ks + 4 * h) * 2;
                    const bf16x8 vf = __builtin_shufflevector(*(const s16x4*)vp, *(const s16x4*)(vp + 16), 0, 1, 2, 3, 4, 5, 6, 7); O[0][d] = MFMA32(vf, pf, O[0][d]); }
            }
        } else {
#pragma unroll 1
        for (int sub = 0; sub < 2; ++sub) {
            bf16x8 kc[NMAP][NS]; s16x4 vlc[2][2], vhc[2][2];
#pragma unroll
            for (int mp = 0; mp < NMAP; ++mp)
#pragma unroll
                for (int s = 0; s < NS; ++s) kc[mp][s] = *(const bf16x8*)(kbuf + ((sub * 32 + r) * KLD + mp * mapoff + s * 16 + h * 8) * 2);
#pragma unroll
            for (int d = 0; d < 2; ++d)
#pragma unroll
                for (int s = 0; s < 2; ++s) { const unsigned char* vp = vbuf + ((d * 32 + r) * VLD + sub * 32 + 16 * s + 4 * h) * 2;
                    vlc[d][s] = *(const s16x4*)vp; vhc[d][s] = *(const s16x4*)(vp + 16); }
#pragma unroll
            for (int mp = 0; mp < NMAP; ++mp) {
                f32x16 S;
#pragma unroll
                for (int i = 0; i < 16; ++i) S[i] = 0.f;
#pragma unroll
                for (int s = 0; s < NS; ++s) S = MFMA32(kc[mp][s], qf[mp][s], S);
                float mx = S[0];
#pragma unroll
                for (int i = 1; i < 16; ++i) mx = fmaxf(mx, S[i]);
                if (!__all(mx - mrun[mp] <= 8.f)) {
                    const float mpair = fmaxf(mx, __shfl_xor(mx, 32));
                    const float mnew = fmaxf(mrun[mp], mpair); const float alpha = __builtin_amdgcn_exp2f(mrun[mp] - mnew); mrun[mp] = mnew;
                    lrun[mp] *= alpha;
#pragma unroll
                    for (int d = 0; d < 2; ++d)
#pragma unroll
                        for (int i = 0; i < 16; ++i) O[mp][d][i] *= alpha;
                }
                const float mcur = mrun[mp];
                float ps = 0.f;
#pragma unroll
                for (int i = 0; i < 16; ++i) { S[i] = __builtin_amdgcn_exp2f(S[i] - mcur); ps += S[i]; }
                lrun[mp] += ps;
#pragma unroll
                for (int s = 0; s < 2; ++s) {
                    u32x4 pw; pw.x = pk2(S[8 * s], S[8 * s + 1]); pw.y = pk2(S[8 * s + 2], S[8 * s + 3]); pw.z = pk2(S[8 * s + 4], S[8 * s + 5]); pw.w = pk2(S[8 * s + 6], S[8 * s + 7]);
                    const bf16x8 pf = __builtin_bit_cast(bf16x8, pw);
#pragma unroll
                    for (int d = 0; d < 2; ++d) { const bf16x8 vf = __builtin_shufflevector(vlc[d][s], vhc[d][s], 0, 1, 2, 3, 4, 5, 6, 7); O[mp][d] = MFMA32(vf, pf, O[mp][d]); }
                }
            }
        }
        }
    };
    gload(0, RA_); sstore(0, RA_); gload(1, RB_); __syncthreads();
    for (int ti = 0; ti < ntiles; ti += 2) {
        gload(ti + 2 < ntiles ? ti + 2 : ntiles - 1, RA_);
        compute(0);
        sstore(1, RB_);
        lds_barrier();
        gload(ti + 3 < ntiles ? ti + 3 : ntiles - 1, RB_);
        compute(1);
        sstore(0, RA_);
        lds_barrier();
    }
    float linv[NMAP];
#pragma unroll
    for (int mp = 0; mp < NMAP; ++mp) { const float lt = lrun[mp] + __shfl_xor(lrun[mp], 32); linv[mp] = 1.f / lt; }
    bf16_t* op = ao.O + (size_t)r * 1024;
    if (NMAP == 1) {
#pragma unroll
        for (int d = 0; d < 2; ++d)
#pragma unroll
            for (int g = 0; g < 4; ++g) { u32x2 w; w.x = pk2(O[0][d][4 * g] * linv[0], O[0][d][4 * g + 1] * linv[0]); w.y = pk2(O[0][d][4 * g + 2] * linv[0], O[0][d][4 * g + 3] * linv[0]);
                *(u32x2*)(op + d * 32 + 8 * g + 4 * h) = w; }
    } else {
        float o[2][16]; float ss = 0.f;
#pragma unroll
        for (int d = 0; d < 2; ++d)
#pragma unroll
            for (int i = 0; i < 16; ++i) { const float v = O[0][d][i] * linv[0] - ao.lam * O[NMAP - 1][d][i] * linv[NMAP - 1]; o[d][i] = v; ss += v * v; }
        ss += __shfl_xor(ss, 32);
        const float rstd = rsqrtf(ss * (1.f / 64.f) + EPS) * ao.oscale;
#pragma unroll
        for (int d = 0; d < 2; ++d)
#pragma unroll
            for (int g = 0; g < 4; ++g) { const int dv = d * 32 + 8 * g + 4 * h; const f32x4 gg = *(const f32x4*)(ao.g + dv);
                u32x2 w; w.x = pk2(o[d][4 * g] * rstd * gg[0], o[d][4 * g + 1] * rstd * gg[1]); w.y = pk2(o[d][4 * g + 2] * rstd * gg[2], o[d][4 * g + 3] * rstd * gg[3]);
                *(u32x2*)(op + dv) = w; }
    }
}

DI void attn_unit(const Params& P, int l, int br  , int seq, int hd, int qb, unsigned char* lds) {
    const int tid = tidx(), lane = tid & 63, w = tid >> 6;
    const bool smp = seq >= 32; const int bq = smp ? seq - 32 : seq; const int tseq = smp ? TP + bq * 1024 : bq * 256; const int slen = smp ? 1024 : 256;
    const int q0 = tseq + qb * 256 + w * 32; const int lb = l * 8 + bq;
    const float* TAB = (const float*)(P.ws + WS_TAB);
    bf16_t* BR = (bf16_t*)(P.ws + WS_BR);
    KSeg sN, sC; AttnOut ao; ao.lam = 0.f; ao.oscale = 1.f; ao.g = nullptr;
    if (br == 0) {
        const int hk = hd >> 1;
        sN.K = (const bf16_t*)(P.ws + WS_KAN) + (size_t)tseq * 128 + hk * 64; sN.ldk = 128; sN.len = slen; sN.ldv = slen;
        sN.Vt = (const bf16_t*)(P.ws + WS_VAN) + (smp ? (size_t)32 * 128 * 256 + ((size_t)bq * 2 + hk) * 64 * 1024 : ((size_t)bq * 2 + hk) * 64 * 256);
        sC.K = (const bf16_t*)(P.ws + WS_KAC) + (size_t)lb * 512 * 128 + hk * 64; sC.ldk = 128; sC.len = 512; sC.ldv = 512;
        sC.Vt = (const bf16_t*)(P.ws + WS_VAC) + ((size_t)lb * 2 + hk) * 64 * 512;
        ao.O = BR + (size_t)q0 * 1024 + hd * 64;
        const bf16_t* Q = (const bf16_t*)(P.ws + WS_QA) + (size_t)q0 * 256 + hd * 64;
        if (!smp) { sC = sN; sN.len = 0; } attn_wave<64, 64, 1>(Q, 256, 0, sC, sN, ao, lane, lds);
    } else if (br == 1) {
        sN.K = (const bf16_t*)(P.ws + WS_KCN) + (size_t)tseq * 256 + hd * 64; sN.ldk = 256; sN.len = slen; sN.ldv = slen;
        sN.Vt = (const bf16_t*)(P.ws + WS_VCN) + (smp ? (size_t)32 * 256 * 256 + ((size_t)bq * 4 + hd) * 64 * 1024 : ((size_t)bq * 4 + hd) * 64 * 256);
        sC.K = (const bf16_t*)(P.ws + WS_KCC) + (size_t)lb * 512 * 256 + hd * 64; sC.ldk = 256; sC.len = 512; sC.ldv = 512;
        sC.Vt = (const bf16_t*)(P.ws + WS_VCC) + ((size_t)lb * 4 + hd) * 64 * 512;
        ao.O = BR + (size_t)q0 * 1024 + 512 + hd * 64; ao.lam = TAB[3072 + l]; ao.oscale = 1.f - TAB[3076 + l]; ao.g = P.in[28] + l * 64;
        const bf16_t* Q = (const bf16_t*)(P.ws + WS_QC) + (size_t)q0 * 256 + hd * 64;
        if (!smp) { sC = sN; sN.len = 0; } attn_wave<64, 32, 2>(Q, 256, 32, sC, sN, ao, lane, lds);
    } else {
        sN.K = (const bf16_t*)(P.ws + WS_KDN) + (size_t)tseq * 384 + hd * 96; sN.ldk = 384; sN.len = slen; sN.ldv = slen;
        sN.Vt = (const bf16_t*)(P.ws + WS_VDN) + (smp ? (size_t)32 * 256 * 256 + ((size_t)bq * 4 + hd) * 64 * 1024 : ((size_t)bq * 4 + hd) * 64 * 256);
        sC.K = (const bf16_t*)(P.ws + WS_KDC) + (size_t)lb * 512 * 384 + hd * 96; sC.ldk = 384; sC.len = 512; sC.ldv = 512;
        sC.Vt = (const bf16_t*)(P.ws + WS_VDC) + ((size_t)lb * 4 + hd) * 64 * 512;
        ao.O = BR + (size_t)q0 * 1024 + 768 + hd * 64;
        const bf16_t* Q = (const bf16_t*)(P.ws + WS_QD) + (size_t)q0 * 384 + hd * 96;
        if (!smp) { sC = sN; sN.len = 0; } attn_wave<96, 96, 1>(Q, 384, 0, sC, sN, ao, lane, lds);
    }
}

DI void gla_unit(const Params& P, int l, int seq, int hd, unsigned char* lds) {
    const int tid = tidx(), lane = tid & 63, w = tid >> 6, fr = lane & 15, fq = lane >> 4;
    const bool smp = seq >= 32; const int bq = smp ? seq - 32 : seq; const int tseq = smp ? TP + bq * 1024 : bq * 256; const int N = smp ? 1024 : 256; const int nch = N >> 6;
    const bf16_t* Z = (const bf16_t*)(P.ws + WS_Z);
    bf16_t* BR = (bf16_t*)(P.ws + WS_BR);
    bf16_t* QD = (bf16_t*)lds; bf16_t* KI = QD + 64 * 40; bf16_t* KDT = KI + 64 * 40; bf16_t* VT = KDT + 32 * 72; bf16_t* AM = VT + 64 * 72; bf16_t* STB = AM + 64 * 72;
    float* GL = (float*)(STB + 64 * 40); float* OL = GL + 32;
    const float qscale = 0.17677669529663687f;
    const int te2 = w >> 1, td = w & 1;
    for (int dir = 0; dir < 2; ++dir) {
        float* OF = (float*)(P.ws + WS_OF) + (size_t)dir * T * 256;
        f32x4 st = (f32x4){0.f, 0.f, 0.f, 0.f};
        { const float* stin = dir ? P.in[6] : P.in[5]; if (smp) st = *(const f32x4*)(stin + ((size_t)(bq * 4 + l) * 4 + hd) * 2048 + (td * 16 + fr) * 64 + te2 * 16 + fq * 4); }
#pragma unroll
        for (int j = 0; j < 4; ++j) STB[(te2 * 16 + fq * 4 + j) * 40 + td * 16 + fr] = f2bf(st[j]);
        const float* gbp = dir ? P.in[22] : P.in[20]; const f32x4 gb = *(const f32x4*)(gbp + l * 128 + hd * 32 + w * 4);
        const int zc_pre = (dir ? ZC_LGB : ZC_LGF) + hd * 32 + w * 4;
        struct Raw { u32x2 q, k, p; u32x4 v; };
        Raw RW0, RW1;
        auto rload = [&](int c, Raw& R) { const int tok = dir ? N - 1 - (c * 64 + lane) : c * 64 + lane; const bf16_t* zr = Z + (size_t)(tseq + tok) * ZLD;
            R.q = *(const u32x2*)(zr + ZC_BQ + hd * 32 + w * 4); R.k = *(const u32x2*)(zr + ZC_BK + hd * 32 + w * 4); R.p = *(const u32x2*)(zr + zc_pre); R.v = *(const u32x4*)(zr + ZC_BV + hd * 64 + w * 8); };
        rload(0, RW0); rload(1, RW1);
        auto chunk = [&](const int c, Raw& R) {
            float q4[4], k4[4], p4[4], v8[8];
            {
              q4[0] = __uint_as_float(R.q.x << 16); q4[1] = __uint_as_float(R.q.x & 0xffff0000u); q4[2] = __uint_as_float(R.q.y << 16); q4[3] = __uint_as_float(R.q.y & 0xffff0000u);
              k4[0] = __uint_as_float(R.k.x << 16); k4[1] = __uint_as_float(R.k.x & 0xffff0000u); k4[2] = __uint_as_float(R.k.y << 16); k4[3] = __uint_as_float(R.k.y & 0xffff0000u);
              p4[0] = __uint_as_float(R.p.x << 16); p4[1] = __uint_as_float(R.p.x & 0xffff0000u); p4[2] = __uint_as_float(R.p.y << 16); p4[3] = __uint_as_float(R.p.y & 0xffff0000u);
#pragma unroll
              for (int j = 0; j < 4; ++j) { v8[2 * j] = __uint_as_float(R.v[j] << 16); v8[2 * j + 1] = __uint_as_float(R.v[j] & 0xffff0000u); } }
            if (c + 2 < nch) rload(c + 2, R);
            float qd[4], ki[4], kd[4], x[4];
#pragma unroll
            for (int j = 0; j < 4; ++j) x[j] = logsigmoidf_(p4[j] + gb[j]) * (1.f / 16.f);
#pragma unroll
            for (int off = 1; off < 64; off <<= 1) {
                float t[4];
#pragma unroll
                for (int j = 0; j < 4; ++j) t[j] = __shfl_up(x[j], off);
#pragma unroll
                for (int j = 0; j < 4; ++j) x[j] += (lane >= off) ? t[j] : 0.f;
            }
            float bl[4];
#pragma unroll
            for (int j = 0; j < 4; ++j) bl[j] = __shfl(x[j], 63);
#pragma unroll
            for (int j = 0; j < 4; ++j) { qd[j] = q4[j] * qscale * __expf(x[j]); ki[j] = k4[j] * __expf(-x[j]); kd[j] = k4[j] * __expf(bl[j] - x[j]); }
            if (lane == 0) { *(f32x4*)(GL + w * 4) = (f32x4){__expf(bl[0]), __expf(bl[1]), __expf(bl[2]), __expf(bl[3])}; }
            { u32x2 t; t.x = pk2(qd[0], qd[1]); t.y = pk2(qd[2], qd[3]); *(u32x2*)(QD + lane * 40 + w * 4) = t;
              t.x = pk2(ki[0], ki[1]); t.y = pk2(ki[2], ki[3]); *(u32x2*)(KI + lane * 40 + w * 4) = t; }
#pragma unroll
            for (int j = 0; j < 4; ++j) KDT[(w * 4 + j) * 72 + lane] = f2bf(kd[j]);
#pragma unroll
            for (int j = 0; j < 8; ++j) VT[(w * 8 + j) * 72 + lane] = f2bf(v8[j]);
            lds_barrier();
#pragma unroll
            for (int q = 0; q < 2; ++q) { const int tile = 2 * w + q, tt = tile >> 2, ts = tile & 3;
                const bf16x8 a = *(const bf16x8*)(KI + (ts * 16 + fr) * 40 + fq * 8), b = *(const bf16x8*)(QD + (tt * 16 + fr) * 40 + fq * 8);
                f32x4 acc = MFMA16(a, b, ((f32x4){0.f, 0.f, 0.f, 0.f}));
                const int t = tt * 16 + fr, s0 = ts * 16 + fq * 4;
#pragma unroll
                for (int j = 0; j < 4; ++j) acc[j] = (s0 + j <= t) ? acc[j] : 0.f;
                u32x2 o2; o2.x = pk2(acc[0], acc[1]); o2.y = pk2(acc[2], acc[3]); *(u32x2*)(AM + t * 72 + s0) = o2; }
            lds_barrier();
#pragma unroll
            for (int q = 0; q < 2; ++q) { const int tile = 2 * w + q, tt = tile >> 2, te = tile & 3;
                f32x4 acc = (f32x4){0.f, 0.f, 0.f, 0.f};
#pragma unroll
                for (int ks = 0; ks < 2; ++ks) { const bf16x8 a = *(const bf16x8*)(VT + (te * 16 + fr) * 72 + ks * 32 + fq * 8), b = *(const bf16x8*)(AM + (tt * 16 + fr) * 72 + ks * 32 + fq * 8); acc = MFMA16(a, b, acc); }
                { const bf16x8 a = *(const bf16x8*)(STB + (te * 16 + fr) * 40 + fq * 8), b = *(const bf16x8*)(QD + (tt * 16 + fr) * 40 + fq * 8); acc = MFMA16(a, b, acc); }
                const int t = tt * 16 + fr;
                { const int tok = dir ? N - 1 - (c * 64 + t) : c * 64 + t; *(f32x4*)(OF + (size_t)(tseq + tok) * 256 + hd * 64 + te * 16 + fq * 4) = acc; } }
            {   const float g = GL[td * 16 + fr]; st *= g;
#pragma unroll
                for (int ks = 0; ks < 2; ++ks) { const bf16x8 a = *(const bf16x8*)(VT + (te2 * 16 + fr) * 72 + ks * 32 + fq * 8), b = *(const bf16x8*)(KDT + (td * 16 + fr) * 72 + ks * 32 + fq * 8); st = MFMA16(a, b, st); } }
            lds_barrier();
#pragma unroll
            for (int j = 0; j < 4; ++j) STB[(te2 * 16 + fq * 4 + j) * 40 + td * 16 + fr] = f2bf(st[j]);
        };
        for (int c = 0; c < nch; c += 2) { chunk(c, RW0); chunk(c + 1, RW1); }
        if (!smp) *(f32x4*)(P.out + (dir ? O_BB : O_BF) + ((size_t)(bq * 4 + l) * 4 + hd) * 2048 + (td * 16 + fr) * 64 + te2 * 16 + fq * 4) = st;
        __syncthreads();
    }
    {
        {
            const float* OF0 = (const float*)(P.ws + WS_OF); const float* OF1 = OF0 + (size_t)T * 256;
            for (int base = tid; base < N * 8; base += 2048) {
                f32x4 a0[4], a1[4], f0[4], f1[4]; u32x4 rr[4];
#pragma unroll
                for (int k = 0; k < 4; ++k) { const int idx = base + 512 * k; const int t = idx >> 3, e0 = (idx & 7) * 8; const size_t tg = (size_t)(tseq + t);
                    a0[k] = *(const f32x4*)(OF0 + tg * 256 + hd * 64 + e0); a1[k] = *(const f32x4*)(OF0 + tg * 256 + hd * 64 + e0 + 4);
                    f0[k] = *(const f32x4*)(OF1 + tg * 256 + hd * 64 + e0); f1[k] = *(const f32x4*)(OF1 + tg * 256 + hd * 64 + e0 + 4);
                    rr[k] = *(const u32x4*)(Z + tg * ZLD + ZC_BR + hd * 64 + e0); }
#pragma unroll
                for (int k = 0; k < 4; ++k) { const int idx = base + 512 * k; const int t = idx >> 3, e0 = (idx & 7) * 8; const size_t tg = (size_t)(tseq + t);
                    float o[8] = {a0[k][0] + f0[k][0], a0[k][1] + f0[k][1], a0[k][2] + f0[k][2], a0[k][3] + f0[k][3], a1[k][0] + f1[k][0], a1[k][1] + f1[k][1], a1[k][2] + f1[k][2], a1[k][3] + f1[k][3]};
                    float ss = 0.f;
#pragma unroll
                    for (int j = 0; j < 8; ++j) ss += o[j] * o[j];
                    ss += __shfl_xor(ss, 1); ss += __shfl_xor(ss, 2); ss += __shfl_xor(ss, 4);
                    const float rstd = rsqrtf(ss * (1.f / 64.f) + EPS);
                    float y[8];
#pragma unroll
                    for (int j = 0; j < 8; ++j) { const float rv = (j & 1) ? __uint_as_float(rr[k][j >> 1] & 0xffff0000u) : __uint_as_float(rr[k][j >> 1] << 16);
                        y[j] = o[j] * rstd * P.in[23][l * 64 + e0 + j] * siluf_(rv); }
                    u32x4 wv; wv.x = pk2(y[0], y[1]); wv.y = pk2(y[2], y[3]); wv.z = pk2(y[4], y[5]); wv.w = pk2(y[6], y[7]);
                    *(u32x4*)(BR + tg * 1024 + 256 + hd * 64 + e0) = wv; }
            }
        }
        __syncthreads();
    }
}
DI void phaseP3(const Params& P, int l, unsigned char* lds) {
    unsigned* ctr = (unsigned*)(P.ws + WS_BAR + 16384) + 1024 + l * 64;
    volatile unsigned* slot = (volatile unsigned*)(lds + LDS_BYTES - 64 + 16);
    for (;;) {
        if (tidx() == 0) *slot = __hip_atomic_fetch_add(ctr, 1u, __ATOMIC_RELAXED, __HIP_MEMORY_SCOPE_AGENT);
        __syncthreads();
        const int u = (int)*slot;
        __syncthreads();
        if (u >= 928 + 656) break;
        if (u >= 928) { conv_items(P, l, 1, u - 928, 1 << 30, lds); continue; }
        int j = u;
        if (j < 32) { gla_unit(P, l, 32 + (j >> 2), j & 3, lds); continue; } j -= 32;
        if (j < 384) { const int bsel = j >> 7, br = bsel == 0 ? 1 : (bsel == 1 ? 2 : 0), r = j & 127; attn_unit(P, l, br, 32 + (r >> 4), (r >> 2) & 3, r & 3, lds); continue; } j -= 384;
        if (j < 128) { gla_unit(P, l, j >> 2, j & 3, lds); continue; } j -= 128;
        { const int br = j / 128, r = j % 128; attn_unit(P, l, br, r >> 2, r & 3, 0, lds); }
    }
}

DI void bf8_to_f(const u32x4 w, float* o) {
#pragma unroll
    for (int j = 0; j < 4; ++j) { o[2 * j] = __uint_as_float(w[j] << 16); o[2 * j + 1] = __uint_as_float(w[j] & 0xffff0000u); }
}
DI void phaseAct(const Params& P, int l) {
    const bf16_t* U = (const bf16_t*)(P.ws + WS_U); const bf16_t* G = (const bf16_t*)(P.ws + WS_G); bf16_t* ACT = (bf16_t*)(P.ws + WS_ACT);
    const float* cw = P.in[37] + (size_t)l * 3 * FF; const float* cb = P.in[38] + (size_t)l * FF;
    const int nthr = gridDim.x * 512;
    for (int gt = blockIdx.x * 512 + tidx(); gt < 256 * 352; gt += nthr) {
        const int fg = gt % 352, slot = gt / 352, f0 = fg * 8, t0 = slot * 64;
        const int pos0 = t0 < TP ? (t0 & 255) : ((t0 - TP) & 1023); const int slen = t0 < TP ? 256 : 1024;
        float w0[8], w1[8], w2[8], bb[8];
#pragma unroll
        for (int j = 0; j < 8; ++j) { w0[j] = cw[f0 + j]; w1[j] = cw[FF + f0 + j]; w2[j] = cw[2 * FF + f0 + j]; bb[j] = cb[f0 + j]; }
        u32x4 um = (u32x4){0u, 0u, 0u, 0u};
        if (pos0 > 0) um = *(const u32x4*)(U + (size_t)(t0 - 1) * FF + f0);
        u32x4 uc = *(const u32x4*)(U + (size_t)t0 * FF + f0);
        for (int i0 = 0; i0 < 64; i0 += 8) {
            u32x4 un[8], gg[8];
#pragma unroll
            for (int i = 0; i < 8; ++i) { const int t = t0 + i0 + i; gg[i] = *(const u32x4*)(G + (size_t)t * FF + f0);
                un[i] = (u32x4){0u, 0u, 0u, 0u}; if (pos0 + i0 + i + 1 < slen) un[i] = *(const u32x4*)(U + (size_t)(t + 1) * FF + f0); }
#pragma unroll
            for (int i = 0; i < 8; ++i) { float a[8], b[8], c[8], g[8], y[8];
                bf8_to_f(um, a); bf8_to_f(uc, b); bf8_to_f(un[i], c); bf8_to_f(gg[i], g);
#pragma unroll
                for (int j = 0; j < 8; ++j) y[j] = gelu_tanh(a[j] * w0[j] + b[j] * w1[j] + c[j] * w2[j] + bb[j]) * g[j];
                u32x4 w; w.x = pk2(y[0], y[1]); w.y = pk2(y[2], y[3]); w.z = pk2(y[4], y[5]); w.w = pk2(y[6], y[7]);
                *(u32x4*)(ACT + (size_t)(t0 + i0 + i) * FF + f0) = w;
                um = uc; uc = un[i]; }
        }
    }
}

#define XB_TMO      128
#define XB_XCNT(j)  (256  + 64 * (j))
#define XB_XSUB(j)  (1280 + 64 * (j))
#define XB_XGEN(j)  (2304 + 64 * (j))
#define XB_TOP      3328
#define XB_TOPGEN   3392
#define XCD_BAR_WORDS 3456
#define XB_SPIN_CAP (1u << 22)
DI unsigned xb_ld(unsigned* p)              { return __hip_atomic_load(p, __ATOMIC_RELAXED, __HIP_MEMORY_SCOPE_AGENT); }
DI unsigned xb_add(unsigned* p, unsigned v) { return __hip_atomic_fetch_add(p, v, __ATOMIC_RELAXED, __HIP_MEMORY_SCOPE_AGENT); }
DI unsigned xb_xcc_id() { return (unsigned)__builtin_amdgcn_s_getreg((3 << 11) | 20) & 0xFu; }
#define XB_SPIN(cond, bar) do { unsigned _sp = 0; while (cond) { __builtin_amdgcn_s_sleep(1); \
    if ((++_sp & 255u) == 0u) { if (xb_ld(&(bar)[XB_TMO])) break; if (_sp > XB_SPIN_CAP) { atomicAdd(&(bar)[XB_TMO], 1u); break; } } } } while (0)
struct XcdBarrier { unsigned* bar; unsigned x; volatile LAS unsigned* st; };
DI XcdBarrier xcd_barrier_post(unsigned* bar, volatile LAS unsigned* st) {
    XcdBarrier b; b.bar = bar; b.x = xb_xcc_id(); b.st = st;
    if (threadIdx.x == 0) (void)xb_add(&bar[XB_XCNT(b.x)], 1u);
    return b;
}
DI void xcd_barrier_complete(unsigned* bar, unsigned x, unsigned& nloc, unsigned& nx) {
    const unsigned G = gridDim.x * gridDim.y * gridDim.z;
    unsigned sum, cnt, mine, sp = 0u;
    for (;;) {
        sum = 0u; cnt = 0u; mine = 0u;
#pragma unroll
        for (unsigned j = 0; j < 16; ++j) { const unsigned c = xb_ld(&bar[XB_XCNT(j)]); sum += c; cnt += (c > 0u) ? 1u : 0u; mine = (j == x) ? c : mine; }
        if (sum == G) break;
        __builtin_amdgcn_s_sleep(1);
        if ((++sp & 255u) == 0u) { if (xb_ld(&bar[XB_TMO])) break; if (sp > XB_SPIN_CAP) { atomicAdd(&bar[XB_TMO], 1u); break; } }
    }
    nloc = mine > 0u ? mine : 1u; nx = cnt > 0u ? cnt : 1u;
}
DI void xcd_barrier(const XcdBarrier& b) {
    asm volatile("s_waitcnt vmcnt(0)" ::: "memory");
    __syncthreads();
    if (threadIdx.x == 0) {
        unsigned* bar = b.bar;
        __builtin_amdgcn_s_waitcnt(0);
        unsigned nloc = b.st[0], nx = b.st[1];
        if (nloc == 0u) { xcd_barrier_complete(bar, b.x, nloc, nx); b.st[0] = nloc; b.st[1] = nx; }
        const unsigned old = xb_add(&bar[XB_XSUB(b.x)], 1u);
        const unsigned gen = old / nloc;
        if (old + 1u == (gen + 1u) * nloc) {
            __builtin_amdgcn_fence(__ATOMIC_RELEASE, "agent");
            asm volatile("s_waitcnt vmcnt(0)" ::: "memory");
            const unsigned og = xb_add(&bar[XB_TOP], 1u);
            const unsigned tg = og / nx;
            if (og + 1u == (tg + 1u) * nx) xb_add(&bar[XB_TOPGEN], 1u);
            else XB_SPIN(xb_ld(&bar[XB_TOPGEN]) == tg, bar);
            __builtin_amdgcn_fence(__ATOMIC_ACQUIRE, "agent");
            xb_add(&bar[XB_XGEN(b.x)], 1u);
            asm volatile("s_waitcnt vmcnt(0)" ::: "memory");
        } else {
            XB_SPIN(xb_ld(&bar[XB_XGEN(b.x)]) == gen, bar);
            __builtin_amdgcn_fence(__ATOMIC_ACQUIRE, "agent");
            asm volatile("s_waitcnt vmcnt(0)" ::: "memory");
        }
    }
    __syncthreads();
}
constexpr int LDS_MISC_OFF = LDS_BYTES - 64;

__global__ void __launch_bounds__(512, 2) fwd_megakernel(Params P) {
    extern __shared__ __attribute__((aligned(16))) unsigned char lds[];
    cg::grid_group grid = cg::this_grid();
    const float* MOD = (const float*)(P.ws + WS_MOD);
    volatile LAS unsigned* misc = (volatile LAS unsigned*)((LAS unsigned char*)lds + LDS_MISC_OFF);
    if (threadIdx.x < 16) misc[threadIdx.x] = 0u;
    __syncthreads();
    XcdBarrier xbar = xcd_barrier_post((unsigned*)(P.ws + WS_BAR), misc);
    for (int pi = P.ph_lo; pi < P.ph_hi; ++pi) {
        int ph; if (pi == 0) ph = 0; else if (pi == 1 + 9 * NL) ph = NPHASE - 1; else { const int q = pi - 1, pl = q / 9, r = q % 9; ph = 1 + 10 * pl + (r < 8 ? r : 9); }
#if DUPMASK
      const int nrep_ = (ph > 0 && ph < NPHASE - 1 && ((DUPMASK >> ((ph - 1) % 10)) & 1)) ? 2 : 1;
      for (int rep_ = 0; rep_ < nrep_; ++rep_) {
        if (rep_) __syncthreads();
#endif
        if (ph == 0) { if (PHM & 1) phase0(P, lds); }
        else if (ph == NPHASE - 1) { NORM_ITEMS_LOOP(norm_rows_items(P, 0, 2, it)); }
        else {
            const int l = (ph - 1) / 10, sp = (ph - 1) % 10;
            if (sp == 0) { if (PHM & 2) phaseA(P, l, lds); }
            else if (sp == 1) { if (PHM & 4) {
                pg8::Gemm g{(const bf16_t*)(P.ws + WS_HB), (const bf16_t*)(P.ws + WS_W1), 1024, 1024, 1024, 0, 0};
                pg8::StaticOrder S; S.init(T, N1, gridDim.x, blockIdx.x, 3);
                pg8::EpiG1 E{(bf16_t*)(P.ws + WS_Z), (bf16_t*)(P.ws + WS_R)};
                pg8::gemm_phase((LAS unsigned char*)lds, g, S, E);

            } } else if (sp == 2) { if (PHM & 8) phaseP2(P, l, lds); }
            else if (sp == 3) { if (PHM & 16) phaseP3(P, l, lds); }
            else if (sp == 4) { if (PHM & 32) {
                pg8::Gemm g{(const bf16_t*)(P.ws + WS_BR), (const bf16_t*)(P.ws + WS_WBR), 1024, 256, 256, (size_t)256 * 2, (size_t)1024 * 256 * 2};
                pg8::StaticOrder S; S.init(T, 1024, gridDim.x, blockIdx.x, 1);
                pg8::EpiMerge E{(const bf16_t*)(P.ws + WS_R), (bf16_t*)(P.ws + WS_HB)};
                pg8::gemm_phase((LAS unsigned char*)lds, g, S, E);
            } } else if (sp == 5) { if (PHM & 64) {
                pg8::Gemm g{(const bf16_t*)(P.ws + WS_HB), (const bf16_t*)(P.ws + WS_WOUT), 1024, 1024, 1024, 0, 0};
                pg8::StaticOrder S; S.init(T, 1024, gridDim.x, blockIdx.x, 0);
                pg8::EpiRes<1> E{P.out, MOD + (size_t)l * 9 * 6144 + 2048, (bf16_t*)(P.ws + WS_Z)};
                pg8::gemm_phase((LAS unsigned char*)lds, g, S, E);
            } } else if (sp == 6) { NORM_ITEMS_LOOP(norm_rows_items(P, l, 1, it)); }
            else if (sp == 7) { if (PHM & 128) {
                pg8::Gemm g{(const bf16_t*)(P.ws + WS_HB) - 1024, (const bf16_t*)(P.ws + WS_WUG), 1024, 1024, 1024, 0, 0, 254};
                pg8::StaticOrder S; S.init(65 * 256, 5632, gridDim.x, blockIdx.x, 0);
                pg8::EpiConv E{(bf16_t*)(P.ws + WS_ACT), P.in[37] + (size_t)l * 3 * FF, P.in[38] + (size_t)l * FF, (float*)(lds + 131072)};
                pg8::gemm_phase((LAS unsigned char*)lds, g, S, E);
            } } else if (sp == 8) { if (PHM & 256) phaseAct(P, l); }
            else { if (PHM & 512) {
                pg8::Gemm g{(const bf16_t*)(P.ws + WS_ACT), (const bf16_t*)(P.ws + WS_WFD), FF, FF, FF, 0, 0};
                pg8::StaticOrder S; S.init(T, 1024, gridDim.x, blockIdx.x, 0);
                pg8::EpiRes<2> E{P.out, MOD + (size_t)l * 9 * 6144 + 5120, (bf16_t*)(P.ws + WS_Z)};
                pg8::gemm_phase((LAS unsigned char*)lds, g, S, E);
            } }
        }
        if (ph > 0 && ph < NPHASE - 1) {
            const int l = (ph - 1) / 10, sp = (ph - 1) % 10; int first, stride;
            if (sp == 7 && l + 1 < NL) { idle_slice(65 * 22, first, stride); conv_items(P, l + 1, 0, first, stride, lds); }
        }
#if DUPMASK
      }
#endif
        if (pi + 1 < P.ph_hi) {
            if (P.ph_hi < 0) grid.sync();
            xcd_barrier(xbar);
#if DUPSYNC
            xcd_barrier(xbar); xcd_barrier(xbar);
#endif
        }
    }
}

#ifndef MK_PER_PHASE
#define MK_PER_PHASE 0
#endif
extern "C" void kernel_launch(void* const* d_in, const int* in_sizes, int n_in, void* d_out, int out_size, void* d_ws, size_t ws_size, hipStream_t stream) {
    static int grid = 0;
    if (grid == 0) {
        int dev = 0, cus = 0, per_cu = 0;
        hipGetDevice(&dev); hipDeviceGetAttribute(&cus, hipDeviceAttributeMultiprocessorCount, dev);
        if (hipFuncSetAttribute((const void*)fwd_megakernel, hipFuncAttributeMaxDynamicSharedMemorySize, LDS_BYTES) != hipSuccess) { fprintf(stderr, "hipFuncSetAttribute failed\n"); grid = -1; return; }
        hipOccupancyMaxActiveBlocksPerMultiprocessor(&per_cu, (const void*)fwd_megakernel, 512, LDS_BYTES);
        if (per_cu < 1) { fprintf(stderr, "occupancy query says %d blocks/CU\n", per_cu); per_cu = 1; }
        (void)hipGetLastError();
        grid = cus * per_cu;
        if (n_in != 41 || ws_size < WS_END) { fprintf(stderr, "kernel_launch: n_in %d ws %zu (need %zu)\n", n_in, ws_size, (size_t)WS_END); grid = -1; return; }
    }
    if (grid < 0) return;
    if (hipMemsetAsync((char*)d_ws + WS_BAR, 0, 32768, stream) != hipSuccess) { fprintf(stderr, "memset of barrier words failed\n"); return; }
    Params p{};
    for (int i = 0; i < 41; ++i) p.in[i] = (const float*)d_in[i];
    p.out = (float*)d_out; p.ws = (unsigned char*)d_ws;
#if MK_PER_PHASE
    for (int ph = 0; ph < NPHASE; ++ph) { p.ph_lo = ph; p.ph_hi = ph + 1; hipLaunchKernelGGL(fwd_megakernel, dim3(grid), dim3(512), LDS_BYTES, stream, p); }
#else
    p.ph_lo = 0; p.ph_hi = 2 + 9 * NL;
    void* args[] = {&p};
    hipError_t e = hipLaunchCooperativeKernel((const void*)fwd_megakernel, dim3(grid), dim3(512), args, LDS_BYTES, stream);
    if (e != hipSuccess) fprintf(stderr, "cooperative launch failed: %s (grid %d)\n", hipGetErrorString(e), grid);
#endif
}
```

```cpp
#include <hip/hip_runtime.h>
#include <hip/hip_cooperative_groups.h>
#include <cstdio>
#include <cstdint>
namespace cg = cooperative_groups;

#define DI __device__ __forceinline__
#define LAS __attribute__((address_space(3)))
typedef unsigned short bf16_t;
typedef short bf16x8 __attribute__((ext_vector_type(8)));
typedef short s16x4 __attribute__((ext_vector_type(4)));
typedef float f32x4 __attribute__((ext_vector_type(4)));
typedef float f32x16 __attribute__((ext_vector_type(16)));
typedef float f32x2 __attribute__((ext_vector_type(2)));
typedef __bf16 bf16x2_t __attribute__((ext_vector_type(2)));
typedef unsigned u32x4 __attribute__((ext_vector_type(4)));
typedef unsigned u32x2 __attribute__((ext_vector_type(2)));

constexpr int T = 16384, TP = 8192, DM = 1024, NL = 4, FF = 2816, WIN = 6528;
constexpr int ZLD = 3072, N1 = 7168, NT_SMALL = 12, NWC = 640;
constexpr int ZC_AQ = 0, ZC_AK = 256, ZC_AV = 384, ZC_BQ = 512, ZC_BK = 640, ZC_BV = 768, ZC_BR = 1024, ZC_CQ = 1280, ZC_CK = 1536, ZC_CV = 1792,
              ZC_DQ = 2048, ZC_DKV = 2240, ZC_DKR = 2368, ZC_LGF = 2400, ZC_LGB = 2528, ZC_DQU = 2656;
constexpr float EPS = 1e-6f, LOG2E = 1.4426950408889634f;
constexpr size_t O_AK = 16777216, O_AV = 20971520, O_BF = 25165824, O_BB = 26214400, O_CK = 27262976, O_CV = 35651584, O_DCKV = 44040192, O_DKR = 48234496;
constexpr size_t SZ_Z = (size_t)T * ZLD * 2, SZ_U = (size_t)T * FF * 2;
constexpr size_t WS_Z = 0, WS_U = 0, WS_G = SZ_U, WS_BR = SZ_Z, WS_OF = WS_BR + (size_t)T * 1024 * 2, SZ_RA = 2 * SZ_U;
static_assert(WS_OF + (size_t)2 * T * 256 * 4 <= SZ_RA, "region A");
constexpr size_t WS_R = SZ_RA, WS_ACT = SZ_RA, SZ_RB = (size_t)T * 4096 * 2;
constexpr size_t WS_RC = WS_R + SZ_RB;
constexpr size_t WS_HB = WS_RC;
constexpr size_t WS_QA = WS_RC, WS_KAN = WS_QA + (size_t)T * 256 * 2, WS_VAN = WS_KAN + (size_t)T * 128 * 2, WS_QC = WS_VAN + (size_t)T * 128 * 2,
                 WS_KCN = WS_QC + (size_t)T * 256 * 2, WS_VCN = WS_KCN + (size_t)T * 256 * 2, WS_QD = WS_VCN + (size_t)T * 256 * 2,
                 WS_KDN = WS_QD + (size_t)T * 384 * 2, WS_VDN = WS_KDN + (size_t)T * 384 * 2, WS_RW = WS_VDN + (size_t)T * 256 * 2;
constexpr size_t WS_W1 = WS_RW, WS_WBR = WS_W1 + (size_t)N1 * 1024 * 2, WS_WOUT = WS_WBR + (size_t)4 * 1024 * 256 * 2, WS_WUG = WS_WOUT + (size_t)1024 * 1024 * 2,
                 WS_WFD = WS_WUG + (size_t)5632 * 1024 * 2, WS_RK = WS_WFD + (size_t)1024 * FF * 2;
constexpr size_t WS_KAC = WS_RK, WS_VAC = WS_KAC + 4194304, WS_KCC = WS_VAC + 4194304, WS_VCC = WS_KCC + 8388608, WS_KDC = WS_VCC + 8388608,
                 WS_VDC = WS_KDC + 12582912, WS_CKVB = WS_VDC + 8388608, WS_WUKVT = WS_CKVB + 4194304, WS_WCT = WS_WUKVT + 524288,
                 WS_MOD = WS_WCT + (size_t)4 * NWC * 1024 * 2, WS_TAB = WS_MOD + (size_t)4 * 9 * 6144 * 4, WS_BAR = WS_TAB + 16384, WS_END = WS_BAR + 32768;
static_assert(WS_END < 505000000ull, "workspace budget");
constexpr int LDS_BYTES = 147456;
constexpr int NPHASE = 42;
#ifndef DUPU
#define DUPU 0
#endif
#ifndef DUPSYNC
#define DUPSYNC 0
#endif
#ifndef DUPMASK
#define DUPMASK 0
#endif
#ifndef PHM
#define PHM 1023
#endif

struct Params { const float* in[41]; float* out; unsigned char* ws; int ph_lo, ph_hi; };

#define MFMA16(a, b, c) __builtin_amdgcn_mfma_f32_16x16x32_bf16((a), (b), (c), 0, 0, 0)
DI int tidx() { int t = threadIdx.x; asm volatile("" : "+v"(t)); return t; }
DI float bf2f(bf16_t v) { return __uint_as_float(((unsigned)v) << 16); }
DI unsigned pk2(float lo, float hi) { f32x2 v = {lo, hi}; bf16x2_t b = __builtin_convertvector(v, bf16x2_t); return __builtin_bit_cast(unsigned, b); }
DI bf16_t f2bf(float f) { return (bf16_t)(pk2(f, 0.f) & 0xffffu); }
DI float wave_sum(float v) {
#pragma unroll
    for (int o = 1; o < 64; o <<= 1) v += __shfl_xor(v, o);
    return v;
}
DI void lds_barrier() { asm volatile("s_waitcnt lgkmcnt(0)" ::: "memory"); __builtin_amdgcn_s_barrier(); asm volatile("" ::: "memory"); }
DI float sigmoidf_(float x) { return 1.f / (1.f + __expf(-x)); }
DI float siluf_(float x) { return x / (1.f + __expf(-x)); }
DI float gelu_tanh(float x) { const float u = 0.7978845608028654f * (x + 0.044715f * x * x * x); const float e = __builtin_amdgcn_exp2f(u * (2.f * LOG2E)); return x * (1.f - __builtin_amdgcn_rcpf(e + 1.f)); }
DI float logsigmoidf_(float x) { return fminf(x, 0.f) - __logf(1.f + __expf(-fabsf(x))); }

namespace pg8 {
constexpr int BM = 256, BK = 64, HALF = 128, HTB = HALF * BK * 2, STAGE_BYTES = 8 * HTB, NXCD = 8, WGM = 8;
__host__ __device__ __forceinline__ int lds_byte(int r, int c) { const int st = (r >> 4) * 2 + (c >> 5), rr = r & 15, cc = c & 31, ob = rr * 64 + cc * 2; return st * 1024 + (ob ^ (((ob >> 9) & 1) << 5)); }
__host__ __device__ __forceinline__ void stage_rc(int b, int& R, int& C) { const int st = b / 1024, sb = b % 1024, swz = sb ^ (((sb >> 9) & 1) << 5); R = (st >> 1) * 16 + swz / 64; C = (st & 1) * 32 + (swz % 64) / 2; }
__host__ __device__ __forceinline__ int perm32(int rho) { const int n = rho >> 4, i = rho & 15; return 8 * (i >> 2) + 4 * n + (i & 3); }

struct Unit { int pm, pn, j; };
struct Gemm { const bf16_t* A; const bf16_t* Bt; int lda, ldb, K; size_t a_joff, b_joff; int a_tile_rows = 256; };

DI void tile_of(int L, int nM, int nN, int& pm, int& pn) {
    const int nwg = nM * nN; int wgid = L;
    { const int q = nwg / NXCD, r = nwg % NXCD, xcd = wgid % NXCD, off = wgid / NXCD; wgid = (xcd < r ? xcd * (q + 1) : r * (q + 1) + (xcd - r) * q) + off; }
    const int nig = WGM * nN, gid = wgid / nig, fm = gid * WGM, gsz = (nM - fm) < WGM ? (nM - fm) : WGM;
    pm = fm + ((wgid % nig) % gsz); pn = (wgid % nig) / gsz;
}
struct StaticOrder {
    int nM, nN, nwg, G, c, jmode;
    DI void init(int M, int N, int G_, int c_, int jm) { nM = M / BM; nN = N / BM; nwg = nM * nN; G = G_; c = c_; jmode = jm; }
    DI bool next(int i, Unit& u) const {
        const int ti = (jmode == 1) ? (i >> 2) : i;
        const long Lx = (long)ti * G + c; if (Lx >= nwg) return false;
        if (jmode == 3) { const int ng = nM * 16;
            if (Lx < ng) { tile_of((int)Lx, nM, 16, u.pm, u.pn); u.pn += nN - 16; } else tile_of((int)Lx - ng, nM, nN - 16, u.pm, u.pn);
            u.j = 0; return true; }
        tile_of((int)Lx, nM, nN, u.pm, u.pn);
        u.j = (jmode == 1) ? (i & 3) : (jmode == 2 ? (u.pm >> 4) : 0);
        return true;
    }
};

template <class Epi>
DI void gemm_phase(LAS unsigned char* lds, const Gemm g, const StaticOrder& S, Epi& E) {
    const int tid = tidx(), wid = __builtin_amdgcn_readfirstlane(tid >> 6), lane = tid & 63, wr = wid >> 2, wc = wid & 3, fr = lane & 15, fq = lane >> 4;
    int Kq = g.K; asm volatile("" : "+s"(Kq));
    const int K = Kq, nt = K / BK;
    unsigned voffA, voffB;
    { int R, C; stage_rc(tid * 16, R, C); const int Rb = (R & ~31) + perm32(R & 31); voffA = (unsigned)(R * g.lda + C) * 2u; voffB = (unsigned)(Rb * g.ldb + C) * 2u; }
    const size_t r64A = (size_t)64 * g.lda * 2, r64B = (size_t)64 * g.ldb * 2;
    const size_t kstep = (size_t)(BK * 2);
    const size_t hstepA = (size_t)HALF * g.lda * 2, hstepB = (size_t)HALF * g.ldb * 2;
    const size_t tstepA = (size_t)g.a_tile_rows * g.lda * 2, tstepB = 2 * hstepB;
    const unsigned ldsw = (unsigned)wid * 1024u;
    const int aoff = lds_byte(wr * 64 + fr, fq * 8), boff = lds_byte(wc * 32 + fr, fq * 8);
#define PG8_SA(b, h) (((b) * 2 + (h)) * HTB)
#define PG8_SB(b, h) ((4 + (b) * 2 + (h)) * HTB)
#define PG8_STAGE(bufoff, gbase, X) do { _Pragma("unroll") for (int _i = 0; _i < 2; ++_i) \
        __builtin_amdgcn_global_load_lds((const unsigned*)((const char*)(gbase) + _i * (r64##X) + (voff##X)), (LAS unsigned*)(lds + (bufoff) + ldsw + _i * 8192), 16, 0, 0); } while (0)
#define PG8_LDA(dst, b, h) do { _Pragma("unroll") for (int m = 0; m < 4; ++m) _Pragma("unroll") for (int k = 0; k < 2; ++k) dst[m][k] = *(const LAS bf16x8*)(lds + PG8_SA(b, h) + aoff + m * 2048 + k * 1024); } while (0)
#define PG8_LDB(dst, b, h) do { _Pragma("unroll") for (int n = 0; n < 2; ++n) _Pragma("unroll") for (int k = 0; k < 2; ++k) dst[n][k] = *(const LAS bf16x8*)(lds + PG8_SB(b, h) + boff + n * 2048 + k * 1024); } while (0)
#define PG8_MMA(ai, bj, At, Bt) do { __builtin_amdgcn_s_setprio(1); _Pragma("unroll") for (int m = 0; m < 4; ++m) _Pragma("unroll") for (int n = 0; n < 2; ++n) _Pragma("unroll") for (int k = 0; k < 2; ++k) \
        acc[ai][bj][m][n] = __builtin_amdgcn_mfma_f32_16x16x32_bf16(Bt[n][k], At[m][k], acc[ai][bj][m][n], 0, 0, 0); __builtin_amdgcn_s_setprio(0); } while (0)
#define PG8_WAIT_V(n) asm volatile("s_waitcnt vmcnt(" #n ")" ::: "memory")
#define PG8_WAIT_L(n) asm volatile("s_waitcnt lgkmcnt(" #n ")" ::: "memory")
#define PG8_BAR __builtin_amdgcn_s_barrier()
#define PG8_SCHED __builtin_amdgcn_sched_barrier(0)
    Unit cur, nxt; int ui = 0;
    if (!S.next(0, cur)) return;
    f32x4 acc[2][2][4][2];
#pragma unroll
    for (int a = 0; a < 2; ++a)
#pragma unroll
        for (int b = 0; b < 2; ++b)
#pragma unroll
            for (int m = 0; m < 4; ++m)
#pragma unroll
                for (int n = 0; n < 2; ++n) acc[a][b][m][n] = (f32x4){0.f, 0.f, 0.f, 0.f};
    bf16x8 At[4][2], B0[2][2], B1[2][2];
    const char* cA = (const char*)g.A + (size_t)cur.pm * tstepA + (size_t)cur.j * g.a_joff; const char* cB = (const char*)g.Bt + (size_t)cur.pn * tstepB + (size_t)cur.j * g.b_joff;
    PG8_STAGE(PG8_SB(0, 0), cB, B); PG8_STAGE(PG8_SB(0, 1), cB + hstepB, B); PG8_STAGE(PG8_SA(0, 0), cA, A); PG8_STAGE(PG8_SA(0, 1), cA + hstepA, A);
    if (wr == 1) PG8_BAR;
    PG8_WAIT_V(2); PG8_BAR;
    PG8_STAGE(PG8_SB(1, 0), cB + kstep, B); PG8_STAGE(PG8_SA(1, 0), cA + kstep, A); PG8_STAGE(PG8_SB(1, 1), cB + hstepB + kstep, B);
    PG8_WAIT_V(6); PG8_BAR;
    for (;;) {
        const bool has_next = S.next(ui + 1, nxt);
        const char* nA = has_next ? (const char*)g.A + (size_t)nxt.pm * tstepA + (size_t)nxt.j * g.a_joff : cA;
        const char* nB = has_next ? (const char*)g.Bt + (size_t)nxt.pn * tstepB + (size_t)nxt.j * g.b_joff : cB;
        for (int t = 0; t < nt; t += 2) {
            const bool last = (t == nt - 2);
            const char* a1 = cA + (size_t)(t + 1) * kstep;
            const char* a2 = last ? nA : cA + (size_t)(t + 2) * kstep; const char* b2 = last ? nB : cB + (size_t)(t + 2) * kstep;
            const char* a3 = a2 + kstep; const char* b3 = b2 + kstep;
            PG8_LDB(B0, 0, 0); PG8_LDB(B1, 0, 1); PG8_SCHED; PG8_LDA(At, 0, 0); PG8_STAGE(PG8_SA(1, 1), a1 + hstepA, A);
            PG8_WAIT_V(8); PG8_WAIT_L(0); PG8_BAR; PG8_MMA(0, 0, At, B0); PG8_MMA(0, 1, At, B1); PG8_BAR; PG8_SCHED;
            PG8_LDA(At, 0, 1); PG8_STAGE(PG8_SB(0, 0), b2, B); PG8_STAGE(PG8_SB(0, 1), b2 + hstepB, B); PG8_STAGE(PG8_SA(0, 0), a2, A);
            PG8_WAIT_V(8); PG8_WAIT_L(0); PG8_BAR; PG8_MMA(1, 0, At, B0); PG8_MMA(1, 1, At, B1); PG8_BAR; PG8_SCHED;
            PG8_LDB(B0, 1, 0); PG8_LDB(B1, 1, 1); PG8_SCHED; PG8_LDA(At, 1, 0); PG8_STAGE(PG8_SA(0, 1), a2 + hstepA, A);
            PG8_WAIT_V(8); PG8_WAIT_L(0); PG8_BAR; PG8_MMA(0, 0, At, B0); PG8_MMA(0, 1, At, B1); PG8_BAR; PG8_SCHED;
            PG8_LDA(At, 1, 1); PG8_STAGE(PG8_SB(1, 0), b3, B); PG8_STAGE(PG8_SB(1, 1), b3 + hstepB, B); PG8_STAGE(PG8_SA(1, 0), a3, A);
            PG8_WAIT_V(8); PG8_WAIT_L(0); PG8_BAR; PG8_MMA(1, 0, At, B0); PG8_MMA(1, 1, At, B1); PG8_BAR; PG8_SCHED;
        }
        if (wr == 0) PG8_BAR;
        E(acc, cur, wr, wc, fr, fq);
        if (!has_next) break;
        cur = nxt; cA = nA; cB = nB; ++ui;
        if (wr == 1) PG8_BAR;
    }
    PG8_WAIT_V(0);
    PG8_BAR;
#undef PG8_SA
#undef PG8_SB
#undef PG8_STAGE
#undef PG8_LDA
#undef PG8_LDB
#undef PG8_MMA
#undef PG8_WAIT_V
#undef PG8_WAIT_L
#undef PG8_BAR
#undef PG8_SCHED
}
typedef f32x4 Acc[2][2][4][2];
DI void zero_acc(Acc& acc) {
#pragma unroll
    for (int a = 0; a < 2; ++a)
#pragma unroll
        for (int b = 0; b < 2; ++b)
#pragma unroll
            for (int m = 0; m < 4; ++m)
#pragma unroll
                for (int n = 0; n < 2; ++n) acc[a][b][m][n] = (f32x4){0.f, 0.f, 0.f, 0.f};
}

struct EpiG1 {
    bf16_t* Z; bf16_t* R;
    DI void operator()(Acc& acc, const Unit& u, int wr, int wc, int fr, int fq) const {
        const int row0 = u.pm * BM + wr * 64 + fr;
        if (u.pn < NT_SMALL) {
#pragma unroll
            for (int ai = 0; ai < 2; ++ai)
#pragma unroll
                for (int m = 0; m < 4; ++m) { const int row = row0 + ai * HALF + m * 16;
#pragma unroll
                    for (int bj = 0; bj < 2; ++bj) { const int col0 = u.pn * BM + bj * HALF + wc * 32 + 8 * fq; const f32x4 v0 = acc[ai][bj][m][0], v1 = acc[ai][bj][m][1];
                        u32x4 w; w.x = pk2(v0[0], v0[1]); w.y = pk2(v0[2], v0[3]); w.z = pk2(v1[0], v1[1]); w.w = pk2(v1[2], v1[3]);
                        *(u32x4*)(Z + (size_t)row * ZLD + col0) = w; } }
        } else {
            const int d0 = (u.pn - NT_SMALL) * 64 + wc * 16 + fq * 4;
#pragma unroll
            for (int ai = 0; ai < 2; ++ai)
#pragma unroll
                for (int m = 0; m < 4; ++m) { const int row = row0 + ai * HALF + m * 16;
                    float r[4][4];
#pragma unroll
                    for (int e = 0; e < 4; ++e) {
                        const float e0 = __expf(-acc[ai][0][m][0][e]), e1 = __expf(-acc[ai][0][m][1][e]), e2 = __expf(-acc[ai][1][m][0][e]), e3 = __expf(-acc[ai][1][m][1][e]);
                        const float i0 = __builtin_amdgcn_rcpf(1.f + e0), i1 = __builtin_amdgcn_rcpf(1.f + e1), i2 = __builtin_amdgcn_rcpf(1.f + e2), i3 = __builtin_amdgcn_rcpf(1.f + e3);
                        r[0][e] = (1.f + e1) * i0; r[1][e] = (1.f + e2) * i1; r[2][e] = (1.f + e3) * i2; r[3][e] = i3; }
#pragma unroll
                    for (int j = 0; j < 4; ++j) { u32x2 w; w.x = pk2(r[j][0], r[j][1]); w.y = pk2(r[j][2], r[j][3]); *(u32x2*)(R + ((size_t)row * 4 + j) * 1024 + d0) = w; } }
        }
        zero_acc(acc);
    }
};
struct EpiMerge {
    const bf16_t* R; bf16_t* O;
    DI void operator()(Acc& acc, const Unit& u, int wr, int wc, int fr, int fq) const {
        const int row0 = u.pm * BM + wr * 64 + fr;
        u32x4 rr[2][4][2];
#pragma unroll
        for (int ai = 0; ai < 2; ++ai)
#pragma unroll
            for (int m = 0; m < 4; ++m)
#pragma unroll
                for (int bj = 0; bj < 2; ++bj) rr[ai][m][bj] = *(const u32x4*)(R + ((size_t)(row0 + ai * HALF + m * 16) * 4 + u.j) * 1024 + u.pn * BM + bj * HALF + wc * 32 + 8 * fq);
#pragma unroll
        for (int ai = 0; ai < 2; ++ai)
#pragma unroll
            for (int m = 0; m < 4; ++m) { const int row = row0 + ai * HALF + m * 16;
#pragma unroll
                for (int bj = 0; bj < 2; ++bj) { const int col0 = u.pn * BM + bj * HALF + wc * 32 + 8 * fq; const u32x4 q = rr[ai][m][bj];
                    f32x4 v0 = acc[ai][bj][m][0], v1 = acc[ai][bj][m][1];
                    v0[0] *= __uint_as_float(q.x << 16); v0[1] *= __uint_as_float(q.x & 0xffff0000u); v0[2] *= __uint_as_float(q.y << 16); v0[3] *= __uint_as_float(q.y & 0xffff0000u);
                    v1[0] *= __uint_as_float(q.z << 16); v1[1] *= __uint_as_float(q.z & 0xffff0000u); v1[2] *= __uint_as_float(q.w << 16); v1[3] *= __uint_as_float(q.w & 0xffff0000u);
                    if (u.j == 3) { u32x4 w; w.x = pk2(v0[0], v0[1]); w.y = pk2(v0[2], v0[3]); w.z = pk2(v1[0], v1[1]); w.w = pk2(v1[2], v1[3]);
                        *(u32x4*)(O + (size_t)row * 1024 + col0) = w; v0 = (f32x4){0.f, 0.f, 0.f, 0.f}; v1 = v0; }
                    acc[ai][bj][m][0] = v0; acc[ai][bj][m][1] = v1; } }
    }
};
template <int MODE> struct EpiRes {
    float* X; const float* gm; bf16_t* D;
    DI void operator()(Acc& acc, const Unit& u, int wr, int wc, int fr, int fq) const {
        const int row0 = u.pm * BM + wr * 64 + fr;
        const int mr = u.pm < 32 ? 0 : 1 + ((u.pm - 32) >> 2);
        const float* gp = gm + (size_t)mr * 6144;
#pragma unroll
        for (int bj = 0; bj < 2; ++bj) { const int col0 = u.pn * BM + bj * HALF + wc * 32 + 8 * fq;
            const f32x4 g0 = *(const f32x4*)(gp + col0), g1 = *(const f32x4*)(gp + col0 + 4);
#pragma unroll
            for (int ai = 0; ai < 2; ++ai) {
                if (MODE == 1) {
#pragma unroll
                    for (int m = 0; m < 4; ++m) { const int row = row0 + ai * HALF + m * 16; const f32x4 d0 = g0 * acc[ai][bj][m][0], d1 = g1 * acc[ai][bj][m][1];
                        u32x4 w; w.x = pk2(d0[0], d0[1]); w.y = pk2(d0[2], d0[3]); w.z = pk2(d1[0], d1[1]); w.w = pk2(d1[2], d1[3]);
                        *(u32x4*)(D + (size_t)row * 1024 + col0) = w; }
                } else {
                    f32x4 x0[4], x1[4]; u32x4 dd[4];
#pragma unroll
                    for (int m = 0; m < 4; ++m) { const int row = row0 + ai * HALF + m * 16; const float* xp = X + (size_t)row * 1024 + col0;
                        x0[m] = *(const f32x4*)xp; x1[m] = *(const f32x4*)(xp + 4); dd[m] = *(const u32x4*)(D + (size_t)row * 1024 + col0); }
#pragma unroll
                    for (int m = 0; m < 4; ++m) { const int row = row0 + ai * HALF + m * 16; float* xp = X + (size_t)row * 1024 + col0;
                        f32x4 a0 = x0[m] + g0 * acc[ai][bj][m][0], a1 = x1[m] + g1 * acc[ai][bj][m][1]; const u32x4 q = dd[m];
                        a0[0] += __uint_as_float(q.x << 16); a0[1] += __uint_as_float(q.x & 0xffff0000u); a0[2] += __uint_as_float(q.y << 16); a0[3] += __uint_as_float(q.y & 0xffff0000u);
                        a1[0] += __uint_as_float(q.z << 16); a1[1] += __uint_as_float(q.z & 0xffff0000u); a1[2] += __uint_as_float(q.w << 16); a1[3] += __uint_as_float(q.w & 0xffff0000u);
                        *(f32x4*)xp = a0; *(f32x4*)(xp + 4) = a1; }
                }
            }
        }
        zero_acc(acc);
    }
};
struct EpiUG {
    bf16_t* U; bf16_t* G;
    DI void operator()(Acc& acc, const Unit& u, int wr, int wc, int fr, int fq) const {
        const int row0 = u.pm * BM + wr * 64 + fr; const int f0 = u.pn * 128 + wc * 32 + 8 * fq;
#pragma unroll
        for (int ai = 0; ai < 2; ++ai)
#pragma unroll
            for (int m = 0; m < 4; ++m) { const int row = row0 + ai * HALF + m * 16;
#pragma unroll
                for (int bj = 0; bj < 2; ++bj) { const f32x4 v0 = acc[ai][bj][m][0], v1 = acc[ai][bj][m][1];
                    u32x4 w; w.x = pk2(v0[0], v0[1]); w.y = pk2(v0[2], v0[3]); w.z = pk2(v1[0], v1[1]); w.w = pk2(v1[2], v1[3]);
                    *(u32x4*)((bj ? G : U) + (size_t)row * FF + f0) = w; } }
        zero_acc(acc);
    }
};
template <int CTRL> DI float dppf(float oldv, float src) { return __builtin_bit_cast(float, __builtin_amdgcn_update_dpp(__builtin_bit_cast(int, oldv), __builtin_bit_cast(int, src), CTRL, 0xf, 0xf, false)); }
struct EpiConv {
    bf16_t* ACT; const float* cw; const float* cb; float* EX;
    DI void operator()(Acc& acc, const Unit& u, int wr, int wc, int fr, int fq) const {
        int fl_ = wc * 32 + 8 * fq; asm volatile("" : "+v"(fl_));
        const int fl = fl_, f0 = u.pn * 128 + fl;
#pragma unroll
        for (int ai = 0; ai < 2; ++ai) { const int g64 = 2 * ai + wr;
            const bool lo = fr == 0; f32x4 e0, e1;
#pragma unroll
            for (int e = 0; e < 4; ++e) { e0[e] = lo ? acc[ai][0][0][0][e] : acc[ai][0][3][0][e]; e1[e] = lo ? acc[ai][0][0][1][e] : acc[ai][0][3][1][e]; }
            float* ep = EX + (g64 * 2 + (lo ? 0 : 1)) * 128 + fl;
            if (fr == 0 || fr == 15) { *(f32x4*)ep = e0; *(f32x4*)(ep + 4) = e1; } }
        lds_barrier();
#pragma unroll
        for (int n = 0; n < 2; ++n) {
            const f32x4 w0 = *(const f32x4*)(cw + f0 + 4 * n), w1 = *(const f32x4*)(cw + FF + f0 + 4 * n), w2 = *(const f32x4*)(cw + 2 * FF + f0 + 4 * n), bb = *(const f32x4*)(cb + f0 + 4 * n);
#pragma unroll
            for (int ai = 0; ai < 2; ++ai) {
                const int g64 = 2 * ai + wr, gp = g64 > 0 ? g64 - 1 : 0, gn = g64 < 3 ? g64 + 1 : 3;
                const f32x4 hp = *(const f32x4*)(EX + (gp * 2 + 1) * 128 + fl + 4 * n), hn = *(const f32x4*)(EX + (gn * 2 + 0) * 128 + fl + 4 * n);
#pragma unroll
                for (int m = 0; m < 4; ++m) {
                    const int r = ai * HALF + wr * 64 + m * 16 + fr; const int R = u.pm * 254 - 1 + r;
                    const bool valid = (r >= 1) && (r <= 254) && (R < T);
                    const int pos = R < TP ? (R & 255) : ((R - TP) & 1023); const int slen = R < TP ? 256 : 1024;
                    const float lm = pos > 0 ? 1.f : 0.f, rm = pos < slen - 1 ? 1.f : 0.f;
                    float y[4];
#pragma unroll
                    for (int e = 0; e < 4; ++e) {
                        const float uc = acc[ai][0][m][n][e];
                        float oldp, oldn;
                        if (m > 0) oldp = dppf<0x121>(uc, acc[ai][0][m > 0 ? m - 1 : 0][n][e]); else oldp = hp[e];
                        if (m < 3) oldn = dppf<0x12F>(uc, acc[ai][0][m < 3 ? m + 1 : 3][n][e]); else oldn = hn[e];
                        const float up = dppf<0x111>(oldp, uc), un = dppf<0x101>(oldn, uc);
                        const float x = lm * w0[e] * up + w1[e] * uc + rm * w2[e] * un + bb[e];
                        y[e] = gelu_tanh(x) * acc[ai][1][m][n][e]; }
                    if (valid) { u32x2 w; w.x = pk2(y[0], y[1]); w.y = pk2(y[2], y[3]); *(u32x2*)(ACT + (size_t)R * FF + f0 + 4 * n) = w; }
                }
                __builtin_amdgcn_sched_barrier(0);
            }
        }
        zero_acc(acc);
    }
};
struct EpiKvC {
    bf16_t* KD; bf16_t* VT;
    DI void operator()(Acc& acc, const Unit& u, int wr, int wc, int fr, int fq) const {
        const int row0 = u.pm * BM + wr * 64 + fr;
#pragma unroll
        for (int ai = 0; ai < 2; ++ai)
#pragma unroll
            for (int m = 0; m < 4; ++m) { const int row = row0 + ai * HALF + m * 16; const int lb = row >> 9, pos = row & 511;
#pragma unroll
                for (int bj = 0; bj < 2; ++bj) { const int h = u.pn * 2 + bj; const int cc = wc * 32 + 8 * fq; const f32x4 v0 = acc[ai][bj][m][0], v1 = acc[ai][bj][m][1];
                    if (wc < 2) { u32x4 w; w.x = pk2(v0[0], v0[1]); w.y = pk2(v0[2], v0[3]); w.z = pk2(v1[0], v1[1]); w.w = pk2(v1[2], v1[3]);
                        *(u32x4*)(KD + ((size_t)row * 4 + h) * 96 + cc) = w; }
                    else { bf16_t* vp = VT + (((size_t)lb * 4 + h) * 64 + (cc - 64)) * 512 + pos;
#pragma unroll
                        for (int e = 0; e < 4; ++e) { vp[(size_t)e * 512] = f2bf(v0[e]); vp[(size_t)(4 + e) * 512] = f2bf(v1[e]); } } } }
        zero_acc(acc);
    }
};
}

struct ColW1 { const float* w; DI const float* operator()(int p) const {
        if (p < 1280) return w + p; if (p < 2400) return w + p + 32; return nullptr; } };
struct ColGate { const float* w; DI const float* operator()(int p) const {
        const int gt = p >> 8, c = p & 255, bj = c >> 7, wc = (c >> 5) & 3, fq = (c >> 3) & 3, n = (c >> 2) & 1, e = c & 3;
        return w + 2432 + (bj * 2 + n) * 1024 + gt * 64 + wc * 16 + fq * 4 + e; } };
struct ColId { const float* w; DI const float* operator()(int p) const { return w + p; } };
struct ColUG { const float* wu; const float* wg; DI const float* operator()(int p) const { const int t = p >> 8, c = p & 255; return c < 128 ? wu + t * 128 + c : wg + t * 128 + (c - 128); } };

template <class ColFn>
DI void tr_tile(const ColFn& cf, int ldsrc, bf16_t* dst, int lddst, int p0, int k0, float* lds) {
    const int tid = tidx(), i = tid & 63, kk = tid >> 6;
    const float* cp = cf(p0 + i);
#pragma unroll
    for (int it = 0; it < 8; ++it) { const int k = kk * 8 + it; lds[k * 65 + i] = cp ? cp[(size_t)(k0 + k) * ldsrc] : 0.f; }
    __syncthreads();
    const int pp = tid >> 3, kc = tid & 7;
    if (cf(p0 + pp) != nullptr) {
        float v[8];
#pragma unroll
        for (int j = 0; j < 8; ++j) v[j] = lds[(kc * 8 + j) * 65 + pp];
        u32x4 w; w.x = pk2(v[0], v[1]); w.y = pk2(v[2], v[3]); w.z = pk2(v[4], v[5]); w.w = pk2(v[6], v[7]);
        *(u32x4*)(dst + (size_t)(p0 + pp) * lddst + k0 + kc * 8) = w;
    }
    __syncthreads();
}

template <class ColFn>
DI void tr_tile4(const ColFn& cf, int ldsrc, bf16_t* dst, int lddst, int p0, int k0, float* lds) {
    const int tid = tidx(), i = tid & 63, kk = tid >> 6;
    const float* cp = cf(p0 + i);
    float v[32];
#pragma unroll
    for (int it = 0; it < 32; ++it) v[it] = cp ? cp[(size_t)(k0 + kk * 32 + it) * ldsrc] : 0.f;
#pragma unroll
    for (int it = 0; it < 32; ++it) lds[(kk * 32 + it) * 65 + i] = v[it];
    __syncthreads();
    const int pp = tid >> 3, kc = tid & 7;
    if (cf(p0 + pp) != nullptr) {
#pragma unroll
        for (int q = 0; q < 4; ++q) { const int kb = (q * 8 + kc) * 8; float x[8];
#pragma unroll
            for (int j = 0; j < 8; ++j) x[j] = lds[(kb + j) * 65 + pp];
            u32x4 w; w.x = pk2(x[0], x[1]); w.y = pk2(x[2], x[3]); w.z = pk2(x[4], x[5]); w.w = pk2(x[6], x[7]);
            *(u32x4*)(dst + (size_t)(p0 + pp) * lddst + k0 + kb) = w; }
    }
    __syncthreads();
}

DI void modnorm_row(const float* xr, const float* g, const float* sh, const float* sc, bf16_t* out, float* xcopy, int lane) {
    f32x4 v[4]; float ss = 0.f;
#pragma unroll
    for (int i = 0; i < 4; ++i) { v[i] = *(const f32x4*)(xr + i * 256 + lane * 4); ss += v[i][0] * v[i][0] + v[i][1] * v[i][1] + v[i][2] * v[i][2] + v[i][3] * v[i][3]; }
    ss = wave_sum(ss); const float rstd = rsqrtf(ss * (1.f / 1024.f) + EPS);
#pragma unroll
    for (int i = 0; i < 4; ++i) { const int c = i * 256 + lane * 4;
        if (xcopy) *(f32x4*)(xcopy + c) = v[i];
        const f32x4 gg = *(const f32x4*)(g + c), s1 = *(const f32x4*)(sc + c), s0 = *(const f32x4*)(sh + c);
        f32x4 y = v[i] * rstd * gg * (s1 + 1.f) + s0;
        u32x2 w; w.x = pk2(y[0], y[1]); w.y = pk2(y[2], y[3]); *(u32x2*)(out + c) = w; }
}
DI int modrow_of(int t) { return t < TP ? 0 : 1 + ((t - TP) >> 10); }

DI void p0_mod_item(const Params& P, int it, float* lds) {
    const int tid = tidx(), l = it / 96, n = (it % 96) * 64 + (tid & 63), kg = tid >> 6;
    float* sv = lds;
    float* red = lds + 9 * 1024;
    for (int idx = tid; idx < 9 * 1024; idx += 512) { const int r = idx >> 10, k = idx & 1023; const float c = r == 0 ? P.in[11][k] : P.in[2][(r - 1) * 1024 + k]; sv[idx] = siluf_(c); }
    __syncthreads();
    float acc[9];
#pragma unroll
    for (int r = 0; r < 9; ++r) acc[r] = 0.f;
    const float* wp = P.in[12] + ((size_t)l * 1024 + kg * 128) * 6144 + n;
    for (int k = 0; k < 128; ++k) { const float w = wp[(size_t)k * 6144];
#pragma unroll
        for (int r = 0; r < 9; ++r) acc[r] += sv[r * 1024 + kg * 128 + k] * w; }
#pragma unroll
    for (int r = 0; r < 9; ++r) red[(kg * 9 + r) * 64 + (tid & 63)] = acc[r];
    __syncthreads();
    float* MOD = (float*)(P.ws + WS_MOD);
    for (int idx = tid; idx < 576; idx += 512) { const int r = idx >> 6, c = idx & 63; float s = 0.f;
#pragma unroll
        for (int q = 0; q < 8; ++q) s += red[(q * 9 + r) * 64 + c];
        const int nn = (it % 96) * 64 + c; MOD[((size_t)l * 9 + r) * 6144 + nn] = s + P.in[13][l * 6144 + nn]; }
    __syncthreads();
}
DI void p0_wc_item(const Params& P, int it, float* lds) {
    const int tid = tidx(), l = it >> 5, k0 = (it & 31) * 32;
    float* src = lds;
    const float* win = P.in[16] + (size_t)l * 1024 * WIN;
    for (int idx = tid; idx < 32 * 224; idx += 512) { const int k = idx / 224, c = idx % 224; float v;
        if (c < 32) v = win[(size_t)(k0 + k) * WIN + 1280 + c];
        else v = win[(size_t)(k0 + k) * WIN + 2080 + (c - 32)] * P.in[29][l * 192 + (c - 32)];
        src[k * 352 + c] = v; }
    __syncthreads();
    bf16_t* WCT = (bf16_t*)(P.ws + WS_WCT);
    for (int n = tid; n < NWC; n += 512) {
        int sc, R, ldu; const float* wu;
        if (n < 128) { sc = 0; R = 16; ldu = 128; wu = P.in[19] + (size_t)l * 16 * 128 + n; }
        else if (n < 256) { sc = 16; R = 16; ldu = 128; wu = P.in[21] + (size_t)l * 16 * 128 + (n - 128); }
        else { sc = 32; R = 192; ldu = 384; wu = P.in[30] + (size_t)l * 192 * 384 + (n - 256); }
        float acc[32];
#pragma unroll
        for (int k = 0; k < 32; ++k) acc[k] = 0.f;
        for (int r = 0; r < R; ++r) { const float w = wu[(size_t)r * ldu];
#pragma unroll
            for (int k = 0; k < 32; ++k) acc[k] += src[k * 352 + sc + r] * w; }
        bf16_t* op = WCT + ((size_t)l * NWC + n) * 1024 + k0;
#pragma unroll
        for (int q = 0; q < 4; ++q) { u32x4 w; w.x = pk2(acc[q * 8], acc[q * 8 + 1]); w.y = pk2(acc[q * 8 + 2], acc[q * 8 + 3]); w.z = pk2(acc[q * 8 + 4], acc[q * 8 + 5]); w.w = pk2(acc[q * 8 + 6], acc[q * 8 + 7]);
            *(u32x4*)(op + q * 8) = w; }
    }
    __syncthreads();
}
constexpr int VT_LD = 66;
DI void vt_flush(const bf16_t* vt, int row_lo, int row_hi, bf16_t* dst_base, int rows_per_head_stride_unused, size_t ldv, int pos0) {
    const int n = (row_hi - row_lo) * 32;
    for (int idx = tidx(); idx < n; idx += 512) { const int r = idx >> 5, c = idx & 31;
        const unsigned v = *(const unsigned*)(vt + (size_t)(row_lo + r) * VT_LD + 2 * c);
        *(unsigned*)(dst_base + (size_t)r * ldv + pos0 + 2 * c) = v; }
}
DI void p0_cache_item(const Params& P, int it, bf16_t* vt) {
    const int tid = tidx(), lane = tid & 63, w = tid >> 6;
    const int b = it >> 5, l = (it >> 3) & 3, pt = it & 7, lb = l * 8 + b, pos0 = pt * 64;
    bf16_t* KAC = (bf16_t*)(P.ws + WS_KAC); bf16_t* KCC = (bf16_t*)(P.ws + WS_KCC); bf16_t* KDC = (bf16_t*)(P.ws + WS_KDC); bf16_t* CKVB = (bf16_t*)(P.ws + WS_CKVB);
    for (int i = w; i < 64; i += 8) { const int pos = pos0 + i; const size_t rb = ((size_t)(b * 4 + l) * 512 + pos);
#pragma unroll
        for (int g = 0; g < 2; ++g) { KAC[((size_t)lb * 512 + pos) * 128 + g * 64 + lane] = f2bf(P.in[3][rb * 128 + g * 64 + lane]);
            vt[(g * 64 + lane) * VT_LD + i] = f2bf(P.in[4][rb * 128 + g * 64 + lane]);
            CKVB[((size_t)lb * 512 + pos) * 128 + g * 64 + lane] = f2bf(P.in[9][rb * 128 + g * 64 + lane]); }
#pragma unroll
        for (int g = 0; g < 4; ++g) { KCC[((size_t)lb * 512 + pos) * 256 + g * 64 + lane] = f2bf(P.in[7][rb * 256 + g * 64 + lane]);
            vt[(128 + g * 64 + lane) * VT_LD + i] = f2bf(P.in[8][rb * 256 + g * 64 + lane]); }
        if (lane < 32) { const bf16_t kr = f2bf(P.in[10][rb * 32 + lane]);
#pragma unroll
            for (int h = 0; h < 4; ++h) KDC[(((size_t)lb * 512 + pos) * 4 + h) * 96 + 64 + lane] = kr; }
    }
    __syncthreads();
    vt_flush(vt, 0, 128, (bf16_t*)(P.ws + WS_VAC) + (size_t)lb * 128 * 512, 0, 512, pos0);
    vt_flush(vt, 128, 384, (bf16_t*)(P.ws + WS_VCC) + (size_t)lb * 256 * 512, 0, 512, pos0);
    __syncthreads();
}
DI void p0_tables(const Params& P) {
    float* TAB = (float*)(P.ws + WS_TAB);
    const int tid = tidx();
    for (int idx = tid; idx < 1024; idx += 512) { const int pos = idx >> 4, i = idx & 15; const float inv = powf(10000.f, -(float)i / 16.f); const float a = (float)pos * inv; TAB[idx * 2] = cosf(a); TAB[idx * 2 + 1] = sinf(a); }
    for (int idx = tid; idx < 512; idx += 512) { const int pos = idx >> 3, i = idx & 7; const float inv = powf(10000.f, -(float)i / 8.f); const float a = (float)pos * inv; TAB[2048 + idx * 2] = cosf(a); TAB[2048 + idx * 2 + 1] = sinf(a); }
    if (tid < 4) { const int l = tid; float s1 = 0.f, s2 = 0.f;
        for (int i = 0; i < 32; ++i) { s1 += P.in[24][l * 32 + i] * P.in[25][l * 32 + i]; s2 += P.in[26][l * 32 + i] * P.in[27][l * 32 + i]; }
        const float li = 0.8f - 0.6f * expf(-0.3f * (float)l);
        TAB[3072 + l] = expf(s1) - expf(s2) + li; TAB[3076 + l] = li; }
}
DI void phase0(const Params& P, unsigned char* lds) {
    const int NMOD = 384, NWC = 128, NCACHE = 256, NTAB = 1, NTR = 64;
    unsigned* ctr = (unsigned*)(P.ws + WS_BAR + 16384) + 1536;
    volatile unsigned* slot = (volatile unsigned*)(lds + LDS_BYTES - 64 + 16);
    for (;;) {
        if (tidx() == 0) *slot = __hip_atomic_fetch_add(ctr, 1u, __ATOMIC_RELAXED, __HIP_MEMORY_SCOPE_AGENT);
        __syncthreads();
        const int it = (int)*slot;
        __syncthreads();
        if (it >= NMOD + NWC + NCACHE + NTAB + NTR) break;
        int j = it;
        if (j < NWC) { p0_wc_item(P, j, (float*)lds); continue; } j -= NWC;
        if (j < NMOD) { p0_mod_item(P, j, (float*)lds); continue; } j -= NMOD;
        if (j < NCACHE) { p0_cache_item(P, j, (bf16_t*)lds); continue; } j -= NCACHE;
        if (j < NTAB) { p0_tables(P); continue; } j -= NTAB;
        { const int l = j >> 4, r = j & 15, pt = r >> 1, kt = r & 1; ColId cf{P.in[32] + (size_t)l * 128 * 512};
          tr_tile(cf, 512, (bf16_t*)(P.ws + WS_WUKVT) + (size_t)l * 512 * 128, 128, pt * 64, kt * 64, (float*)lds); }
    }
}

DI void norm_rows_items(const Params& P, int l, int which  , int it) {
    const int tid = tidx(), lane = tid & 63, w = tid >> 6, tb = it * 32 + w;
    const float* MOD = (const float*)(P.ws + WS_MOD);
    float* X = P.out;
    const bool from_in = (which == 0 && l == 0);
    const float* src = from_in ? (tb < TP ? P.in[0] + (size_t)tb * 1024 : P.in[1] + (size_t)(tb - TP) * 1024) : X + (size_t)tb * 1024;
    f32x4 v[4][4]; float ss[4];
#pragma unroll
    for (int r = 0; r < 4; ++r)
#pragma unroll
        for (int i = 0; i < 4; ++i) v[r][i] = *(const f32x4*)(src + (size_t)r * 8 * 1024 + i * 256 + lane * 4);
    if (which == 1) {
        const bf16_t* dp = (const bf16_t*)(P.ws + WS_Z) + (size_t)tb * 1024;
#pragma unroll
        for (int r = 0; r < 4; ++r)
#pragma unroll
            for (int i = 0; i < 4; ++i) { const u32x2 d = *(const u32x2*)(dp + (size_t)r * 8 * 1024 + i * 256 + lane * 4);
                v[r][i][0] += __uint_as_float(d.x << 16); v[r][i][1] += __uint_as_float(d.x & 0xffff0000u); v[r][i][2] += __uint_as_float(d.y << 16); v[r][i][3] += __uint_as_float(d.y & 0xffff0000u); }
    }
#pragma unroll
    for (int r = 0; r < 4; ++r) { float q = 0.f;
#pragma unroll
        for (int i = 0; i < 4; ++i) q += v[r][i][0] * v[r][i][0] + v[r][i][1] * v[r][i][1] + v[r][i][2] * v[r][i][2] + v[r][i][3] * v[r][i][3];
        ss[r] = q; }
#pragma unroll
    for (int o = 1; o < 64; o <<= 1) {
#pragma unroll
        for (int r = 0; r < 4; ++r) ss[r] += __shfl_xor(ss[r], o); }
    if (which == 2) {
#pragma unroll
        for (int i = 0; i < 4; ++i) { const int c = i * 256 + lane * 4; const f32x4 gg = *(const f32x4*)(P.in[40] + c);
#pragma unroll
            for (int r = 0; r < 4; ++r) *(f32x4*)(X + (size_t)(tb + 8 * r) * 1024 + c) = v[r][i] * rsqrtf(ss[r] * (1.f / 1024.f) + EPS) * gg; }
        return;
    }
    const float* mp = MOD + ((size_t)l * 9 + modrow_of(tb)) * 6144 + (which ? 3072 : 0);
    const float* g = (which ? P.in[15] : P.in[14]) + l * 1024;
    bf16_t* out = (bf16_t*)(P.ws + WS_HB) + (size_t)tb * 1024;
#pragma unroll
    for (int i = 0; i < 4; ++i) { const int c = i * 256 + lane * 4;
        const f32x4 gg = *(const f32x4*)(g + c), s1 = *(const f32x4*)(mp + 1024 + c), s0 = *(const f32x4*)(mp + c); const f32x4 gs = gg * (s1 + 1.f);
#pragma unroll
        for (int r = 0; r < 4; ++r) {
            if (from_in) *(f32x4*)(X + (size_t)(tb + 8 * r) * 1024 + c) = v[r][i];
            const f32x4 y = v[r][i] * rsqrtf(ss[r] * (1.f / 1024.f) + EPS) * gs + s0;
            u32x2 wv; wv.x = pk2(y[0], y[1]); wv.y = pk2(y[2], y[3]); *(u32x2*)(out + (size_t)r * 8 * 1024 + c) = wv; } }
}
DI void conv_items(const Params& P, int l, int group, int first, int stride, unsigned char* lds) {
    const int N_W1A = 152, N_W1G = 256, N_CP = 84, N_BR = 64, N_OUT = 64, N_UG = 352, N_FD = 176;
    bf16_t* W1 = (bf16_t*)(P.ws + WS_W1);
    if (group == 0) {
        for (int it = first; it < N_W1A + N_W1G + N_CP; it += stride) {
            int j = it;
            if (j < N_W1A) { ColW1 cf{P.in[16] + (size_t)l * 1024 * WIN}; tr_tile4(cf, WIN, W1, 1024, (j >> 2) * 64, (j & 3) * 256, (float*)lds); continue; } j -= N_W1A;
            if (j < N_W1G) { ColGate cf{P.in[16] + (size_t)l * 1024 * WIN}; tr_tile4(cf, WIN, W1 + (size_t)ZLD * 1024, 1024, (j >> 2) * 64, (j & 3) * 256, (float*)lds); continue; } j -= N_W1G;
            {
                const int r0 = j * 8; const int tid = tidx();
                for (int idx = tid; idx < 8 * 128; idx += 512) { const int r = r0 + (idx >> 7), c = (idx & 127) * 8;
                    u32x4 v = (u32x4){0u, 0u, 0u, 0u};
                    if (r < NWC) v = *(const u32x4*)((const bf16_t*)(P.ws + WS_WCT) + ((size_t)l * NWC + r) * 1024 + c);
                    *(u32x4*)(W1 + (size_t)(2400 + r) * 1024 + c) = v; } }
        }
    } else {
        for (int it = first; it < N_BR + N_OUT + N_UG + N_FD; it += stride) {
            int j = it;
            if (j < N_BR) { const int br = j >> 4, r = j & 15; ColId cf{P.in[33] + ((size_t)l * 4 + br) * 256 * 1024};
                tr_tile4(cf, 1024, (bf16_t*)(P.ws + WS_WBR) + (size_t)br * 1024 * 256, 256, r * 64, 0, (float*)lds); continue; } j -= N_BR;
            if (j < N_OUT) { ColId cf{P.in[34] + (size_t)l * 1024 * 1024}; tr_tile4(cf, 1024, (bf16_t*)(P.ws + WS_WOUT), 1024, (j >> 2) * 64, (j & 3) * 256, (float*)lds); continue; } j -= N_OUT;
            if (j < N_UG) { ColUG cf{P.in[35] + (size_t)l * 1024 * FF, P.in[36] + (size_t)l * 1024 * FF}; tr_tile4(cf, FF, (bf16_t*)(P.ws + WS_WUG), 1024, (j >> 2) * 64, (j & 3) * 256, (float*)lds); continue; } j -= N_UG;
            { ColId cf{P.in[39] + (size_t)l * FF * 1024}; tr_tile4(cf, 1024, (bf16_t*)(P.ws + WS_WFD), FF, (j / 11) * 64, (j % 11) * 256, (float*)lds); }
        }
    }
}
DI void idle_slice(int nwg, int& first, int& stride) {
    const int G = gridDim.x, rem = nwg % G, c = blockIdx.x;
    if (rem == 0) { first = c; stride = G; } else if (c >= rem) { first = c - rem; stride = G - rem; } else { first = 1 << 30; stride = 1; }
}
DI void phaseA(const Params& P, int l, unsigned char* lds) {
    if (l == 0) {
        pg8::Gemm g{(const bf16_t*)(P.ws + WS_CKVB), (const bf16_t*)(P.ws + WS_WUKVT), 128, 128, 128, 0, (size_t)512 * 128 * 2};
        pg8::StaticOrder S; S.init(T, 512, gridDim.x, blockIdx.x, 2);
        pg8::EpiKvC E{(bf16_t*)(P.ws + WS_KDC), (bf16_t*)(P.ws + WS_VDC)};
        pg8::gemm_phase(( LAS unsigned char*)lds, g, S, E);
        __syncthreads();
    }
    if (l == 0) conv_items(P, 0, 0, blockIdx.x, gridDim.x, lds);
    for (int it = blockIdx.x; it < 512; it += gridDim.x) norm_rows_items(P, l, 0, it);
}

DI float rope_lane(float v, int e, int style, int prow, int pcol, const float* TAB) {
    if (style == 0) { const float pv = __shfl_xor(v, 16); const int i = e & 31; const int pos = (e & 32) ? pcol : prow; const float* cs = TAB + (pos * 16 + (i & 15)) * 2;
        return (i & 16) ? v * cs[0] + pv * cs[1] : v * cs[0] - pv * cs[1]; }
    else { const float pv = __shfl_xor(v, 8); const int i = e & 31; const int pos = (i & 16) ? pcol : prow; const float* cs = TAB + 2048 + (pos * 8 + (i & 7)) * 2;
        return (i & 8) ? v * cs[0] + pv * cs[1] : v * cs[0] - pv * cs[1]; }
}
DI void phaseP2(const Params& P, int l, unsigned char* lds) {
    const int tid = tidx(), lane = tid & 63, w = tid >> 6;
    bf16_t* vt = (bf16_t*)lds;
    bf16_t* AK = (bf16_t*)(lds + 640 * VT_LD * 2);
    const bf16_t* Z = (const bf16_t*)(P.ws + WS_Z);
    const float* TAB = (const float*)(P.ws + WS_TAB);
    bf16_t* QA = (bf16_t*)(P.ws + WS_QA); bf16_t* KAN = (bf16_t*)(P.ws + WS_KAN); bf16_t* QC = (bf16_t*)(P.ws + WS_QC); bf16_t* KCN = (bf16_t*)(P.ws + WS_KCN);
    bf16_t* QD = (bf16_t*)(P.ws + WS_QD); bf16_t* KDN = (bf16_t*)(P.ws + WS_KDN);
    const float scA = 0.125f * LOG2E, scC = 0.17677669529663687f * LOG2E, scD = 0.10206207261596575f * LOG2E;
    for (int it = blockIdx.x; it < 256; it += gridDim.x) {
        const int t0 = it * 64; const bool smp = t0 >= TP;
        const int seqlen = smp ? 1024 : 256; const int pos0 = smp ? ((t0 - TP) & 1023) : (t0 & 255); const int bq = smp ? ((t0 - TP) >> 10) : (t0 >> 8);
        const int L = lane, hl = L & 15, l7 = L & 7;
        bf16x8 wfr[4][4];
        { const bf16_t* Wt = (const bf16_t*)(P.ws + WS_WUKVT) + (size_t)l * 512 * 128 + (size_t)((w >> 1) * 128 + (w & 1) * 64) * 128;
#pragma unroll
          for (int nt = 0; nt < 4; ++nt)
#pragma unroll
              for (int ks = 0; ks < 4; ++ks) wfr[nt][ks] = *(const bf16x8*)(Wt + (size_t)(nt * 16 + (lane & 15)) * 128 + ks * 32 + (lane >> 4) * 8); }
        for (int i = w; i < 64; i += 8) {
            const int t = t0 + i, pos = pos0 + i; const int prow = pos >> 6, pcol = pos & 63;
            const bf16_t* zr = Z + (size_t)t * ZLD + 4 * L;
            const size_t orow = ((size_t)(bq * 4 + l) * 256 + pos);
            u32x2 raw[9];
            { const int cb[9] = {0, 256, 1280, 1536, 1792, 2048, 2304, 2560, 2816};
#pragma unroll
              for (int q = 0; q < 9; ++q) raw[q] = *(const u32x2*)(zr + cb[q]); }
            auto un4 = [&](const u32x2 r, float* o) { o[0] = __uint_as_float(r.x << 16); o[1] = __uint_as_float(r.x & 0xffff0000u); o[2] = __uint_as_float(r.y << 16); o[3] = __uint_as_float(r.y & 0xffff0000u); };
            auto pk4 = [&](const float* o) { u32x2 r; r.x = pk2(o[0], o[1]); r.y = pk2(o[2], o[3]); return r; };
            auto red16 = [&](float x) { x += __shfl_xor(x, 1); x += __shfl_xor(x, 2); x += __shfl_xor(x, 4); x += __shfl_xor(x, 8); return x; };
            auto ropeA = [&](float* v) {
                const int pp = (hl & 8) ? pcol : prow; const bool hi = hl & 4;
#pragma unroll
                for (int j = 0; j < 4; ++j) { const float pv = __shfl_xor(v[j], 4); const float* cs = TAB + (pp * 16 + 4 * (hl & 3) + j) * 2; v[j] = hi ? v[j] * cs[0] + pv * cs[1] : v[j] * cs[0] - pv * cs[1]; } };
            auto ropeC = [&](float* v) {
                const int pp = (l7 & 4) ? pcol : prow; const bool hi = l7 & 2;
#pragma unroll
                for (int j = 0; j < 4; ++j) { const float pv = __shfl_xor(v[j], 2); const float* cs = TAB + 2048 + (pp * 8 + 4 * (l7 & 1) + j) * 2; v[j] = hi ? v[j] * cs[0] + pv * cs[1] : v[j] * cs[0] - pv * cs[1]; } };
            float v[4], u4[4];
            { un4(raw[0], v); const float ss = red16(v[0] * v[0] + v[1] * v[1] + v[2] * v[2] + v[3] * v[3]); const float rs = rsqrtf(ss * (1.f / 64.f) + EPS);
              const f32x4 g = *(const f32x4*)(P.in[17] + l * 64 + 4 * hl);
#pragma unroll
              for (int j = 0; j < 4; ++j) v[j] *= rs * g[j];
              if (smp) ropeA(v);
#pragma unroll
              for (int j = 0; j < 4; ++j) v[j] *= scA;
              *(u32x2*)(QA + (size_t)t * 256 + 4 * L) = pk4(v); }
            { un4(raw[1], v); const float ss = red16(v[0] * v[0] + v[1] * v[1] + v[2] * v[2] + v[3] * v[3]); const float rs = rsqrtf(ss * (1.f / 64.f) + EPS);
              const f32x4 g = *(const f32x4*)(P.in[18] + l * 64 + 4 * hl);
#pragma unroll
              for (int j = 0; j < 4; ++j) u4[j] = v[j] * rs * g[j];
              if (smp) ropeA(u4);
              if (L < 32) { *(u32x2*)(KAN + (size_t)t * 128 + 4 * L) = pk4(u4); if (!smp) *(f32x4*)(P.out + O_AK + orow * 128 + 4 * L) = (f32x4){u4[0], u4[1], u4[2], u4[3]}; }
              else {
#pragma unroll
                  for (int j = 0; j < 4; ++j) vt[(4 * (L - 32) + j) * VT_LD + i] = f2bf(v[j]);
                  if (!smp) *(f32x4*)(P.out + O_AV + orow * 128 + 4 * (L - 32)) = (f32x4){v[0], v[1], v[2], v[3]}; } }
            { un4(raw[2], v); if (smp) ropeC(v);
#pragma unroll
              for (int j = 0; j < 4; ++j) v[j] *= scC;
              *(u32x2*)(QC + (size_t)t * 256 + 4 * L) = pk4(v);
              un4(raw[3], v); if (smp) ropeC(v);
              *(u32x2*)(KCN + (size_t)t * 256 + 4 * L) = pk4(v);
              if (!smp) *(f32x4*)(P.out + O_CK + orow * 256 + 4 * L) = (f32x4){v[0], v[1], v[2], v[3]};
              un4(raw[4], v);
#pragma unroll
              for (int j = 0; j < 4; ++j) vt[(128 + 4 * L + j) * VT_LD + i] = f2bf(v[j]);
              if (!smp) *(f32x4*)(P.out + O_CV + orow * 256 + 4 * L) = (f32x4){v[0], v[1], v[2], v[3]}; }
            float b8[4], b9[4];
            un4(raw[5], b8); un4(raw[6], b9);
            const float s8 = b8[0] * b8[0] + b8[1] * b8[1] + b8[2] * b8[2] + b8[3] * b8[3], s9 = b9[0] * b9[0] + b9[1] * b9[1] + b9[2] * b9[2] + b9[3] * b9[3];
            const float rq = rsqrtf(wave_sum(L < 48 ? s8 : 0.f) * (1.f / 192.f) + EPS);
            const float rk = rsqrtf(wave_sum((L >= 48 ? s8 : 0.f) + (L < 16 ? s9 : 0.f)) * (1.f / 128.f) + EPS);
            if (L >= 48 || L < 16) {
                const int m = L >= 48 ? 4 * (L - 48) : 64 + 4 * L; const f32x4 g = *(const f32x4*)(P.in[31] + l * 128 + m);
                float c4[4];
#pragma unroll
                for (int j = 0; j < 4; ++j) c4[j] = (L >= 48 ? b8[j] : b9[j]) * rk * g[j];
                if (!smp) *(f32x4*)(P.out + O_DCKV + orow * 128 + m) = (f32x4){c4[0], c4[1], c4[2], c4[3]};
                *(u32x2*)(AK + i * 136 + m) = pk4(c4); }
            {
              if (smp) ropeC(b9);
              if (L >= 16 && L < 24) { const int i0 = 4 * (L - 16);
                  if (!smp) *(f32x4*)(P.out + O_DKR + orow * 32 + i0) = (f32x4){b9[0], b9[1], b9[2], b9[3]};
                  const u32x2 kb = pk4(b9);
#pragma unroll
                  for (int h = 0; h < 4; ++h) *(u32x2*)(KDN + ((size_t)t * 4 + h) * 96 + 64 + i0) = kb; } }
            { un4(raw[7], v);
#pragma unroll
              for (int j = 0; j < 4; ++j) v[j] *= rq;
              { float rv[4] = {v[0], v[1], v[2], v[3]}; if (smp) ropeC(rv); const int w0 = (4 * L) % 96; if (smp && w0 >= 64) { v[0] = rv[0]; v[1] = rv[1]; v[2] = rv[2]; v[3] = rv[3]; } }
#pragma unroll
              for (int j = 0; j < 4; ++j) v[j] *= scD;
              if (L >= 24) *(u32x2*)(QD + (size_t)t * 384 + 4 * L - 96) = pk4(v); }
            { un4(raw[8], v);
#pragma unroll
              for (int j = 0; j < 4; ++j) v[j] *= rq;
              { float rv[4] = {v[0], v[1], v[2], v[3]}; if (smp) ropeC(rv); const int w0 = (64 + 4 * L) % 96; if (smp && w0 >= 64) { v[0] = rv[0]; v[1] = rv[1]; v[2] = rv[2]; v[3] = rv[3]; } }
#pragma unroll
              for (int j = 0; j < 4; ++j) v[j] *= scD;
              if (L < 56) *(u32x2*)(QD + (size_t)t * 384 + 160 + 4 * L) = pk4(v); }
        }
        __syncthreads();
        {
            const int h = w >> 1, half = w & 1, fr = lane & 15, fq = lane >> 4;
#pragma unroll
            for (int nt = 0; nt < 4; ++nt) {
#pragma unroll
                for (int tt = 0; tt < 4; ++tt) {
                    f32x4 acc = (f32x4){0.f, 0.f, 0.f, 0.f};
#pragma unroll
                    for (int ks = 0; ks < 4; ++ks) { const bf16x8 a = *(const bf16x8*)(AK + (tt * 16 + fr) * 136 + ks * 32 + fq * 8); acc = MFMA16(wfr[nt][ks], a, acc); }
                    const int tl = tt * 16 + fr;
                    if (half == 0) { u32x2 o2; o2.x = pk2(acc[0], acc[1]); o2.y = pk2(acc[2], acc[3]); *(u32x2*)(KDN + ((size_t)(t0 + tl) * 4 + h) * 96 + nt * 16 + fq * 4) = o2; }
                    else {
#pragma unroll
                        for (int j = 0; j < 4; ++j) vt[(384 + h * 64 + nt * 16 + fq * 4 + j) * VT_LD + tl] = f2bf(acc[j]); }
                }
            }
        }
        __syncthreads();
        {
            const size_t ldv = seqlen;
            bf16_t* va = (bf16_t*)(P.ws + WS_VAN) + (smp ? (size_t)32 * 128 * 256 + (size_t)bq * 128 * 1024 : (size_t)bq * 128 * 256);
            bf16_t* vc = (bf16_t*)(P.ws + WS_VCN) + (smp ? (size_t)32 * 256 * 256 + (size_t)bq * 256 * 1024 : (size_t)bq * 256 * 256);
            bf16_t* vd = (bf16_t*)(P.ws + WS_VDN) + (smp ? (size_t)32 * 256 * 256 + (size_t)bq * 256 * 1024 : (size_t)bq * 256 * 256);
            vt_flush(vt, 0, 128, va, 0, ldv, pos0); vt_flush(vt, 128, 384, vc, 0, ldv, pos0); vt_flush(vt, 384, 640, vd, 0, ldv, pos0);
        }
        __syncthreads();
    }
}

#define MFMA32(a, b, c) __builtin_amdgcn_mfma_f32_32x32x16_bf16((a), (b), (c), 0, 0, 0)
struct KSeg { const bf16_t* K; const bf16_t* Vt; int ldk, ldv, len; };
struct AttnOut { bf16_t* O; float lam, oscale; const float* g; };

template <int DKROW, int DK, int NMAP>
DI void attn_wave(const bf16_t* Q, int ldq, int mapoff, const KSeg s0, const KSeg s1, const AttnOut ao, int lane, unsigned char* lds) {
    constexpr int NS = DK / 16, KLD = DKROW + 8, VLD = 72, KBUF = 64 * KLD * 2, VBUF = 64 * VLD * 2, CPR = DKROW / 8, NCH = 64 * CPR;
    const int tid = tidx();
    const int r = lane & 31, h = lane >> 5;
    bf16x8 qf[NMAP][NS];
#pragma unroll
    for (int mp = 0; mp < NMAP; ++mp)
#pragma unroll
        for (int s = 0; s < NS; ++s) qf[mp][s] = *(const bf16x8*)(Q + (size_t)r * ldq + mp * mapoff + s * 16 + h * 8);
    f32x16 O[NMAP][2]; float mrun[NMAP], lrun[NMAP];
#pragma unroll
    for (int mp = 0; mp < NMAP; ++mp) { mrun[mp] = -1e30f; lrun[mp] = 0.f;
#pragma unroll
        for (int d = 0; d < 2; ++d)
#pragma unroll
            for (int i = 0; i < 16; ++i) O[mp][d][i] = 0.f; }
    const int nt0 = s0.len >> 6, ntiles = nt0 + (s1.len >> 6);
    const int krow0 = tid / CPR, kch0 = tid % CPR, krow1 = (tid + 512) / CPR, kch1 = (tid + 512) % CPR, vrow = tid >> 3, vch = tid & 7;
    struct Stg { u32x4 k0, k1, v; };
    Stg RA_, RB_;
    auto gload = [&](int ti, Stg& R) {
        const bool first = ti < nt0; const KSeg& sg = first ? s0 : s1; const int kb = (first ? ti : ti - nt0) * 64;
        R.k0 = *(const u32x4*)(sg.K + (size_t)(kb + krow0) * sg.ldk + kch0 * 8);
        if (NCH > 512) { if (tid + 512 < NCH) R.k1 = *(const u32x4*)(sg.K + (size_t)(kb + krow1) * sg.ldk + kch1 * 8); }
        R.v = *(const u32x4*)(sg.Vt + (size_t)vrow * sg.ldv + kb + vch * 8);
    };
    auto sstore = [&](int b, const Stg& R) {
        unsigned char* kb_ = lds + b * (KBUF + VBUF); unsigned char* vb_ = kb_ + KBUF;
        *(u32x4*)(kb_ + (krow0 * KLD + kch0 * 8) * 2) = R.k0;
        if (NCH > 512) { if (tid + 512 < NCH) *(u32x4*)(kb_ + (krow1 * KLD + kch1 * 8) * 2) = R.k1; }
        *(u32x4*)(vb_ + (vrow * VLD + vch * 8) * 2) = R.v;
    };
    auto compute = [&](int bsel) __attribute__((always_inline)) {
        const unsigned char* kbuf = lds + bsel * (KBUF + VBUF); const unsigned char* vbuf = kbuf + KBUF;
        if constexpr (NMAP == 1) {
            f32x16 S0, S1;
#pragma unroll
            for (int i = 0; i < 16; ++i) { S0[i] = 0.f; S1[i] = 0.f; }
#pragma unroll
            for (int s = 0; s < NS; ++s) { const bf16x8 k0 = *(const bf16x8*)(kbuf + (r * KLD + s * 16 + h * 8) * 2); S0 = MFMA32(k0, qf[0][s], S0); }
#pragma unroll
            for (int s = 0; s < NS; ++s) { const bf16x8 k1 = *(const bf16x8*)(kbuf + ((32 + r) * KLD + s * 16 + h * 8) * 2); S1 = MFMA32(k1, qf[0][s], S1); }
            float mx = fmaxf(S0[0], S1[0]);
#pragma unroll
            for (int i = 1; i < 16; ++i) mx = fmaxf(mx, fmaxf(S0[i], S1[i]));
            if (!__all(mx - mrun[0] <= 8.f)) {
                const float mp = fmaxf(mx, __shfl_xor(mx, 32));
                const float mnew = fmaxf(mrun[0], mp); const float alpha = __builtin_amdgcn_exp2f(mrun[0] - mnew); mrun[0] = mnew;
                lrun[0] *= alpha;
#pragma unroll
                for (int d = 0; d < 2; ++d)
#pragma unroll
                    for (int i = 0; i < 16; ++i) O[0][d][i] *= alpha;
            }
            const float mcur = mrun[0];
            float ps = 0.f;
#pragma unroll
            for (int i = 0; i < 16; ++i) { S0[i] = __builtin_amdgcn_exp2f(S0[i] - mcur); S1[i] = __builtin_amdgcn_exp2f(S1[i] - mcur); ps += S0[i] + S1[i]; }
            lrun[0] += ps;
#pragma unroll
            for (int ks = 0; ks < 4; ++ks) { const int s8 = 8 * (ks & 1);
                u32x4 pw;
                if (ks < 2) { pw.x = pk2(S0[s8], S0[s8 + 1]); pw.y = pk2(S0[s8 + 2], S0[s8 + 3]); pw.z = pk2(S0[s8 + 4], S0[s8 + 5]); pw.w = pk2(S0[s8 + 6], S0[s8 + 7]); }
                else { pw.x = pk2(S1[s8], S1[s8 + 1]); pw.y = pk2(S1[s8 + 2], S1[s8 + 3]); pw.z = pk2(S1[s8 + 4], S1[s8 + 5]); pw.w = pk2(S1[s8 + 6], S1[s8 + 7]); }
                const bf16x8 pf = __builtin_bit_cast(bf16x8, pw);
#pragma unroll
                for (int d = 0; d < 2; ++d) { const unsigned char* vp = vbuf + ((d * 32 + r) * VLD + 16 * ks + 4 * h) * 2;
                    const bf16x8 vf = __builtin_shufflevector(*(const s16x4*)vp, *(const s16x4*)(vp + 16), 0, 1, 2, 3, 4, 5, 6, 7); O[0][d] = MFMA32(vf, pf, O[0][d]); }
            }
        } else {
#pragma unroll 1
        for (int sub = 0; sub < 2; ++sub) {
            bf16x8 kc[NMAP][NS]; s16x4 vlc[2][2], vhc[2][2];
#pragma unroll
            for (int mp = 0; mp < NMAP; ++mp)
#pragma unroll
                for (int s = 0; s < NS; ++s) kc[mp][s] = *(const bf16x8*)(kbuf + ((sub * 32 + r) * KLD + mp * mapoff + s * 16 + h * 8) * 2);
#pragma unroll
            for (int d = 0; d < 2; ++d)
#pragma unroll
                for (int s = 0; s < 2; ++s) { const unsigned char* vp = vbuf + ((d * 32 + r) * VLD + sub * 32 + 16 * s + 4 * h) * 2;
                    vlc[d][s] = *(const s16x4*)vp; vhc[d][s] = *(const s16x4*)(vp + 16); }
#pragma unroll
            for (int mp = 0; mp < NMAP; ++mp) {
                f32x16 S;
#pragma unroll
                for (int i = 0; i < 16; ++i) S[i] = 0.f;
#pragma unroll
                for (int s = 0; s < NS; ++s) S = MFMA32(kc[mp][s], qf[mp][s], S);
                float mx = S[0];
#pragma unroll
                for (int i = 1; i < 16; ++i) mx = fmaxf(mx, S[i]);
                if (!__all(mx - mrun[mp] <= 8.f)) {
                    const float mpair = fmaxf(mx, __shfl_xor(mx, 32));
                    const float mnew = fmaxf(mrun[mp], mpair); const float alpha = __builtin_amdgcn_exp2f(mrun[mp] - mnew); mrun[mp] = mnew;
                    lrun[mp] *= alpha;
#pragma unroll
                    for (int d = 0; d < 2; ++d)
#pragma unroll
                        for (int i = 0; i < 16; ++i) O[mp][d][i] *= alpha;
                }
                const float mcur = mrun[mp];
                float ps = 0.f;
#pragma unroll
                for (int i = 0; i < 16; ++i) { S[i] = __builtin_amdgcn_exp2f(S[i] - mcur); ps += S[i]; }
                lrun[mp] += ps;
#pragma unroll
                for (int s = 0; s < 2; ++s) {
                    u32x4 pw; pw.x = pk2(S[8 * s], S[8 * s + 1]); pw.y = pk2(S[8 * s + 2], S[8 * s + 3]); pw.z = pk2(S[8 * s + 4], S[8 * s + 5]); pw.w = pk2(S[8 * s + 6], S[8 * s + 7]);
                    const bf16x8 pf = __builtin_bit_cast(bf16x8, pw);
#pragma unroll
                    for (int d = 0; d < 2; ++d) { const bf16x8 vf = __builtin_shufflevector(vlc[d][s], vhc[d][s], 0, 1, 2, 3, 4, 5, 6, 7); O[mp][d] = MFMA32(vf, pf, O[mp][d]); }
                }
            }
        }
        }
    };
    gload(0, RA_); sstore(0, RA_); gload(1, RB_); __syncthreads();
    for (int ti = 0; ti < ntiles; ti += 2) {
        gload(ti + 2 < ntiles ? ti + 2 : ntiles - 1, RA_);
        compute(0);
        sstore(1, RB_);
        lds_barrier();
        gload(ti + 3 < ntiles ? ti + 3 : ntiles - 1, RB_);
        compute(1);
        sstore(0, RA_);
        lds_barrier();
    }
    float linv[NMAP];
#pragma unroll
    for (int mp = 0; mp < NMAP; ++mp) { const float lt = lrun[mp] + __shfl_xor(lrun[mp], 32); linv[mp] = 1.f / lt; }
    bf16_t* op = ao.O + (size_t)r * 1024;
    if (NMAP == 1) {
#pragma unroll
        for (int d = 0; d < 2; ++d)
#pragma unroll
            for (int g = 0; g < 4; ++g) { u32x2 w; w.x = pk2(O[0][d][4 * g] * linv[0], O[0][d][4 * g + 1] * linv[0]); w.y = pk2(O[0][d][4 * g + 2] * linv[0], O[0][d][4 * g + 3] * linv[0]);
                *(u32x2*)(op + d * 32 + 8 * g + 4 * h) = w; }
    } else {
        float o[2][16]; float ss = 0.f;
#pragma unroll
        for (int d = 0; d < 2; ++d)
#pragma unroll
            for (int i = 0; i < 16; ++i) { const float v = O[0][d][i] * linv[0] - ao.lam * O[NMAP - 1][d][i] * linv[NMAP - 1]; o[d][i] = v; ss += v * v; }
        ss += __shfl_xor(ss, 32);
        const float rstd = rsqrtf(ss * (1.f / 64.f) + EPS) * ao.oscale;
#pragma unroll
        for (int d = 0; d < 2; ++d)
#pragma unroll
            for (int g = 0; g < 4; ++g) { const int dv = d * 32 + 8 * g + 4 * h; const f32x4 gg = *(const f32x4*)(ao.g + dv);
                u32x2 w; w.x = pk2(o[d][4 * g] * rstd * gg[0], o[d][4 * g + 1] * rstd * gg[1]); w.y = pk2(o[d][4 * g + 2] * rstd * gg[2], o[d][4 * g + 3] * rstd * gg[3]);
                *(u32x2*)(op + dv) = w; }
    }
}

DI void attn_unit(const Params& P, int l, int br  , int seq, int hd, int qb, unsigned char* lds) {
    const int tid = tidx(), lane = tid & 63, w = tid >> 6;
    const bool smp = seq >= 32; const int bq = smp ? seq - 32 : seq; const int tseq = smp ? TP + bq * 1024 : bq * 256; const int slen = smp ? 1024 : 256;
    const int q0 = tseq + qb * 256 + w * 32; const int lb = l * 8 + bq;
    const float* TAB = (const float*)(P.ws + WS_TAB);
    bf16_t* BR = (bf16_t*)(P.ws + WS_BR);
    KSeg sN, sC; AttnOut ao; ao.lam = 0.f; ao.oscale = 1.f; ao.g = nullptr;
    if (br == 0) {
        const int hk = hd >> 1;
        sN.K = (const bf16_t*)(P.ws + WS_KAN) + (size_t)tseq * 128 + hk * 64; sN.ldk = 128; sN.len = slen; sN.ldv = slen;
        sN.Vt = (const bf16_t*)(P.ws + WS_VAN) + (smp ? (size_t)32 * 128 * 256 + ((size_t)bq * 2 + hk) * 64 * 1024 : ((size_t)bq * 2 + hk) * 64 * 256);
        sC.K = (const bf16_t*)(P.ws + WS_KAC) + (size_t)lb * 512 * 128 + hk * 64; sC.ldk = 128; sC.len = 512; sC.ldv = 512;
        sC.Vt = (const bf16_t*)(P.ws + WS_VAC) + ((size_t)lb * 2 + hk) * 64 * 512;
        ao.O = BR + (size_t)q0 * 1024 + hd * 64;
        const bf16_t* Q = (const bf16_t*)(P.ws + WS_QA) + (size_t)q0 * 256 + hd * 64;
        if (!smp) { sC = sN; sN.len = 0; } attn_wave<64, 64, 1>(Q, 256, 0, sC, sN, ao, lane, lds);
    } else if (br == 1) {
        sN.K = (const bf16_t*)(P.ws + WS_KCN) + (size_t)tseq * 256 + hd * 64; sN.ldk = 256; sN.len = slen; sN.ldv = slen;
        sN.Vt = (const bf16_t*)(P.ws + WS_VCN) + (smp ? (size_t)32 * 256 * 256 + ((size_t)bq * 4 + hd) * 64 * 1024 : ((size_t)bq * 4 + hd) * 64 * 256);
        sC.K = (const bf16_t*)(P.ws + WS_KCC) + (size_t)lb * 512 * 256 + hd * 64; sC.ldk = 256; sC.len = 512; sC.ldv = 512;
        sC.Vt = (const bf16_t*)(P.ws + WS_VCC) + ((size_t)lb * 4 + hd) * 64 * 512;
        ao.O = BR + (size_t)q0 * 1024 + 512 + hd * 64; ao.lam = TAB[3072 + l]; ao.oscale = 1.f - TAB[3076 + l]; ao.g = P.in[28] + l * 64;
        const bf16_t* Q = (const bf16_t*)(P.ws + WS_QC) + (size_t)q0 * 256 + hd * 64;
        if (!smp) { sC = sN; sN.len = 0; } attn_wave<64, 32, 2>(Q, 256, 32, sC, sN, ao, lane, lds);
    } else {
        sN.K = (const bf16_t*)(P.ws + WS_KDN) + (size_t)tseq * 384 + hd * 96; sN.ldk = 384; sN.len = slen; sN.ldv = slen;
        sN.Vt = (const bf16_t*)(P.ws + WS_VDN) + (smp ? (size_t)32 * 256 * 256 + ((size_t)bq * 4 + hd) * 64 * 1024 : ((size_t)bq * 4 + hd) * 64 * 256);
        sC.K = (const bf16_t*)(P.ws + WS_KDC) + (size_t)lb * 512 * 384 + hd * 96; sC.ldk = 384; sC.len = 512; sC.ldv = 512;
        sC.Vt = (const bf16_t*)(P.ws + WS_VDC) + ((size_t)lb * 4 + hd) * 64 * 512;
        ao.O = BR + (size_t)q0 * 1024 + 768 + hd * 64;
        const bf16_t* Q = (const bf16_t*)(P.ws + WS_QD) + (size_t)q0 * 384 + hd * 96;
        if (!smp) { sC = sN; sN.len = 0; } attn_wave<96, 96, 1>(Q, 384, 0, sC, sN, ao, lane, lds);
    }
}

DI void gla_unit(const Params& P, int l, int seq, int hd, unsigned char* lds) {
    const int tid = tidx(), lane = tid & 63, w = tid >> 6, fr = lane & 15, fq = lane >> 4;
    const bool smp = seq >= 32; const int bq = smp ? seq - 32 : seq; const int tseq = smp ? TP + bq * 1024 : bq * 256; const int N = smp ? 1024 : 256; const int nch = N >> 6;
    const bf16_t* Z = (const bf16_t*)(P.ws + WS_Z);
    bf16_t* BR = (bf16_t*)(P.ws + WS_BR);
    bf16_t* QD = (bf16_t*)lds; bf16_t* KI = QD + 64 * 40; bf16_t* KDT = KI + 64 * 40; bf16_t* VT = KDT + 32 * 72; bf16_t* AM = VT + 64 * 72; bf16_t* STB = AM + 64 * 72;
    float* GL = (float*)(STB + 64 * 40); float* OL = GL + 32;
    const float qscale = 0.17677669529663687f;
    const int te2 = w >> 1, td = w & 1;
    for (int dir = 0; dir < 2; ++dir) {
        float* OF = (float*)(P.ws + WS_OF) + (size_t)dir * T * 256;
        f32x4 st = (f32x4){0.f, 0.f, 0.f, 0.f};
        { const float* stin = dir ? P.in[6] : P.in[5]; if (smp) st = *(const f32x4*)(stin + ((size_t)(bq * 4 + l) * 4 + hd) * 2048 + (td * 16 + fr) * 64 + te2 * 16 + fq * 4); }
#pragma unroll
        for (int j = 0; j < 4; ++j) STB[(te2 * 16 + fq * 4 + j) * 40 + td * 16 + fr] = f2bf(st[j]);
        const float* gbp = dir ? P.in[22] : P.in[20]; const f32x4 gb = *(const f32x4*)(gbp + l * 128 + hd * 32 + w * 4);
        const int zc_pre = (dir ? ZC_LGB : ZC_LGF) + hd * 32 + w * 4;
        struct Raw { u32x2 q, k, p; u32x4 v; };
        Raw RW0, RW1;
        auto rload = [&](int c, Raw& R) { const int tok = dir ? N - 1 - (c * 64 + lane) : c * 64 + lane; const bf16_t* zr = Z + (size_t)(tseq + tok) * ZLD;
            R.q = *(const u32x2*)(zr + ZC_BQ + hd * 32 + w * 4); R.k = *(const u32x2*)(zr + ZC_BK + hd * 32 + w * 4); R.p = *(const u32x2*)(zr + zc_pre); R.v = *(const u32x4*)(zr + ZC_BV + hd * 64 + w * 8); };
        rload(0, RW0); rload(1, RW1);
        auto chunk = [&](const int c, Raw& R) {
            float q4[4], k4[4], p4[4], v8[8];
            {
              q4[0] = __uint_as_float(R.q.x << 16); q4[1] = __uint_as_float(R.q.x & 0xffff0000u); q4[2] = __uint_as_float(R.q.y << 16); q4[3] = __uint_as_float(R.q.y & 0xffff0000u);
              k4[0] = __uint_as_float(R.k.x << 16); k4[1] = __uint_as_float(R.k.x & 0xffff0000u); k4[2] = __uint_as_float(R.k.y << 16); k4[3] = __uint_as_float(R.k.y & 0xffff0000u);
              p4[0] = __uint_as_float(R.p.x << 16); p4[1] = __uint_as_float(R.p.x & 0xffff0000u); p4[2] = __uint_as_float(R.p.y << 16); p4[3] = __uint_as_float(R.p.y & 0xffff0000u);
#pragma unroll
              for (int j = 0; j < 4; ++j) { v8[2 * j] = __uint_as_float(R.v[j] << 16); v8[2 * j + 1] = __uint_as_float(R.v[j] & 0xffff0000u); } }
            if (c + 2 < nch) rload(c + 2, R);
            float qd[4], ki[4], kd[4], x[4];
#pragma unroll
            for (int j = 0; j < 4; ++j) x[j] = logsigmoidf_(p4[j] + gb[j]) * (1.f / 16.f);
#pragma unroll
            for (int off = 1; off < 64; off <<= 1) {
                float t[4];
#pragma unroll
                for (int j = 0; j < 4; ++j) t[j] = __shfl_up(x[j], off);
#pragma unroll
                for (int j = 0; j < 4; ++j) x[j] += (lane >= off) ? t[j] : 0.f;
            }
            float bl[4];
#pragma unroll
            for (int j = 0; j < 4; ++j) bl[j] = __shfl(x[j], 63);
#pragma unroll
            for (int j = 0; j < 4; ++j) { qd[j] = q4[j] * qscale * __expf(x[j]); ki[j] = k4[j] * __expf(-x[j]); kd[j] = k4[j] * __expf(bl[j] - x[j]); }
            if (lane == 0) { *(f32x4*)(GL + w * 4) = (f32x4){__expf(bl[0]), __expf(bl[1]), __expf(bl[2]), __expf(bl[3])}; }
            { u32x2 t; t.x = pk2(qd[0], qd[1]); t.y = pk2(qd[2], qd[3]); *(u32x2*)(QD + lane * 40 + w * 4) = t;
              t.x = pk2(ki[0], ki[1]); t.y = pk2(ki[2], ki[3]); *(u32x2*)(KI + lane * 40 + w * 4) = t; }
#pragma unroll
            for (int j = 0; j < 4; ++j) KDT[(w * 4 + j) * 72 + lane] = f2bf(kd[j]);
#pragma unroll
            for (int j = 0; j < 8; ++j) VT[(w * 8 + j) * 72 + lane] = f2bf(v8[j]);
            lds_barrier();
#pragma unroll
            for (int q = 0; q < 2; ++q) { const int tile = 2 * w + q, tt = tile >> 2, ts = tile & 3;
                const bf16x8 a = *(const bf16x8*)(KI + (ts * 16 + fr) * 40 + fq * 8), b = *(const bf16x8*)(QD + (tt * 16 + fr) * 40 + fq * 8);
                f32x4 acc = MFMA16(a, b, ((f32x4){0.f, 0.f, 0.f, 0.f}));
                const int t = tt * 16 + fr, s0 = ts * 16 + fq * 4;
#pragma unroll
                for (int j = 0; j < 4; ++j) acc[j] = (s0 + j <= t) ? acc[j] : 0.f;
                u32x2 o2; o2.x = pk2(acc[0], acc[1]); o2.y = pk2(acc[2], acc[3]); *(u32x2*)(AM + t * 72 + s0) = o2; }
            lds_barrier();
#pragma unroll
            for (int q = 0; q < 2; ++q) { const int tile = 2 * w + q, tt = tile >> 2, te = tile & 3;
                f32x4 acc = (f32x4){0.f, 0.f, 0.f, 0.f};
#pragma unroll
                for (int ks = 0; ks < 2; ++ks) { const bf16x8 a = *(const bf16x8*)(VT + (te * 16 + fr) * 72 + ks * 32 + fq * 8), b = *(const bf16x8*)(AM + (tt * 16 + fr) * 72 + ks * 32 + fq * 8); acc = MFMA16(a, b, acc); }
                { const bf16x8 a = *(const bf16x8*)(STB + (te * 16 + fr) * 40 + fq * 8), b = *(const bf16x8*)(QD + (tt * 16 + fr) * 40 + fq * 8); acc = MFMA16(a, b, acc); }
                const int t = tt * 16 + fr;
                { const int tok = dir ? N - 1 - (c * 64 + t) : c * 64 + t; *(f32x4*)(OF + (size_t)(tseq + tok) * 256 + hd * 64 + te * 16 + fq * 4) = acc; } }
            {   const float g = GL[td * 16 + fr]; st *= g;
#pragma unroll
                for (int ks = 0; ks < 2; ++ks) { const bf16x8 a = *(const bf16x8*)(VT + (te2 * 16 + fr) * 72 + ks * 32 + fq * 8), b = *(const bf16x8*)(KDT + (td * 16 + fr) * 72 + ks * 32 + fq * 8); st = MFMA16(a, b, st); } }
            lds_barrier();
#pragma unroll
            for (int j = 0; j < 4; ++j) STB[(te2 * 16 + fq * 4 + j) * 40 + td * 16 + fr] = f2bf(st[j]);
        };
        for (int c = 0; c < nch; c += 2) { chunk(c, RW0); chunk(c + 1, RW1); }
        if (!smp) *(f32x4*)(P.out + (dir ? O_BB : O_BF) + ((size_t)(bq * 4 + l) * 4 + hd) * 2048 + (td * 16 + fr) * 64 + te2 * 16 + fq * 4) = st;
        __syncthreads();
    }
    {
        {
            const float* OF0 = (const float*)(P.ws + WS_OF); const float* OF1 = OF0 + (size_t)T * 256;
            for (int base = tid; base < N * 8; base += 2048) {
                f32x4 a0[4], a1[4], f0[4], f1[4]; u32x4 rr[4];
#pragma unroll
                for (int k = 0; k < 4; ++k) { const int idx = base + 512 * k; const int t = idx >> 3, e0 = (idx & 7) * 8; const size_t tg = (size_t)(tseq + t);
                    a0[k] = *(const f32x4*)(OF0 + tg * 256 + hd * 64 + e0); a1[k] = *(const f32x4*)(OF0 + tg * 256 + hd * 64 + e0 + 4);
                    f0[k] = *(const f32x4*)(OF1 + tg * 256 + hd * 64 + e0); f1[k] = *(const f32x4*)(OF1 + tg * 256 + hd * 64 + e0 + 4);
                    rr[k] = *(const u32x4*)(Z + tg * ZLD + ZC_BR + hd * 64 + e0); }
#pragma unroll
                for (int k = 0; k < 4; ++k) { const int idx = base + 512 * k; const int t = idx >> 3, e0 = (idx & 7) * 8; const size_t tg = (size_t)(tseq + t);
                    float o[8] = {a0[k][0] + f0[k][0], a0[k][1] + f0[k][1], a0[k][2] + f0[k][2], a0[k][3] + f0[k][3], a1[k][0] + f1[k][0], a1[k][1] + f1[k][1], a1[k][2] + f1[k][2], a1[k][3] + f1[k][3]};
                    float ss = 0.f;
#pragma unroll
                    for (int j = 0; j < 8; ++j) ss += o[j] * o[j];
                    ss += __shfl_xor(ss, 1); ss += __shfl_xor(ss, 2); ss += __shfl_xor(ss, 4);
                    const float rstd = rsqrtf(ss * (1.f / 64.f) + EPS);
                    float y[8];
#pragma unroll
                    for (int j = 0; j < 8; ++j) { const float rv = (j & 1) ? __uint_as_float(rr[k][j >> 1] & 0xffff0000u) : __uint_as_float(rr[k][j >> 1] << 16);
                        y[j] = o[j] * rstd * P.in[23][l * 64 + e0 + j] * siluf_(rv); }
                    u32x4 wv; wv.x = pk2(y[0], y[1]); wv.y = pk2(y[2], y[3]); wv.z = pk2(y[4], y[5]); wv.w = pk2(y[6], y[7]);
                    *(u32x4*)(BR + tg * 1024 + 256 + hd * 64 + e0) = wv; }
            }
        }
        __syncthreads();
    }
}
DI void phaseP3(const Params& P, int l, unsigned char* lds) {
    unsigned* ctr = (unsigned*)(P.ws + WS_BAR + 16384) + 1024 + l * 64;
    volatile unsigned* slot = (volatile unsigned*)(lds + LDS_BYTES - 64 + 16);
    for (;;) {
        if (tidx() == 0) *slot = __hip_atomic_fetch_add(ctr, 1u, __ATOMIC_RELAXED, __HIP_MEMORY_SCOPE_AGENT);
        __syncthreads();
        const int u = (int)*slot;
        __syncthreads();
        if (u >= 928 + 656) break;
        if (u >= 928) { conv_items(P, l, 1, u - 928, 1 << 30, lds); continue; }
        int j = u;
        if (j < 32) { gla_unit(P, l, 32 + (j >> 2), j & 3, lds); continue; } j -= 32;
        if (j < 384) { const int bsel = j >> 7, br = bsel == 0 ? 1 : (bsel == 1 ? 2 : 0), r = j & 127; attn_unit(P, l, br, 32 + (r >> 4), (r >> 2) & 3, r & 3, lds); continue; } j -= 384;
        if (j < 128) { gla_unit(P, l, j >> 2, j & 3, lds); continue; } j -= 128;
        { const int br = j / 128, r = j % 128; attn_unit(P, l, br, r >> 2, r & 3, 0, lds); }
    }
}

DI void bf8_to_f(const u32x4 w, float* o) {
#pragma unroll
    for (int j = 0; j < 4; ++j) { o[2 * j] = __uint_as_float(w[j] << 16); o[2 * j + 1] = __uint_as_float(w[j] & 0xffff0000u); }
}
DI void phaseAct(const Params& P, int l) {
    const bf16_t* U = (const bf16_t*)(P.ws + WS_U); const bf16_t* G = (const bf16_t*)(P.ws + WS_G); bf16_t* ACT = (bf16_t*)(P.ws + WS_ACT);
    const float* cw = P.in[37] + (size_t)l * 3 * FF; const float* cb = P.in[38] + (size_t)l * FF;
    const int nthr = gridDim.x * 512;
    for (int gt = blockIdx.x * 512 + tidx(); gt < 256 * 352; gt += nthr) {
        const int fg = gt % 352, slot = gt / 352, f0 = fg * 8, t0 = slot * 64;
        const int pos0 = t0 < TP ? (t0 & 255) : ((t0 - TP) & 1023); const int slen = t0 < TP ? 256 : 1024;
        float w0[8], w1[8], w2[8], bb[8];
#pragma unroll
        for (int j = 0; j < 8; ++j) { w0[j] = cw[f0 + j]; w1[j] = cw[FF + f0 + j]; w2[j] = cw[2 * FF + f0 + j]; bb[j] = cb[f0 + j]; }
        u32x4 um = (u32x4){0u, 0u, 0u, 0u};
        if (pos0 > 0) um = *(const u32x4*)(U + (size_t)(t0 - 1) * FF + f0);
        u32x4 uc = *(const u32x4*)(U + (size_t)t0 * FF + f0);
        for (int i0 = 0; i0 < 64; i0 += 8) {
            u32x4 un[8], gg[8];
#pragma unroll
            for (int i = 0; i < 8; ++i) { const int t = t0 + i0 + i; gg[i] = *(const u32x4*)(G + (size_t)t * FF + f0);
                un[i] = (u32x4){0u, 0u, 0u, 0u}; if (pos0 + i0 + i + 1 < slen) un[i] = *(const u32x4*)(U + (size_t)(t + 1) * FF + f0); }
#pragma unroll
            for (int i = 0; i < 8; ++i) { float a[8], b[8], c[8], g[8], y[8];
                bf8_to_f(um, a); bf8_to_f(uc, b); bf8_to_f(un[i], c); bf8_to_f(gg[i], g);
#pragma unroll
                for (int j = 0; j < 8; ++j) y[j] = gelu_tanh(a[j] * w0[j] + b[j] * w1[j] + c[j] * w2[j] + bb[j]) * g[j];
                u32x4 w; w.x = pk2(y[0], y[1]); w.y = pk2(y[2], y[3]); w.z = pk2(y[4], y[5]); w.w = pk2(y[6], y[7]);
                *(u32x4*)(ACT + (size_t)(t0 + i0 + i) * FF + f0) = w;
                um = uc; uc = un[i]; }
        }
    }
}

#define XB_TMO      128
#define XB_XCNT(j)  (256  + 64 * (j))
#define XB_XSUB(j)  (1280 + 64 * (j))
#define XB_XGEN(j)  (2304 + 64 * (j))
#define XB_TOP      3328
#define XB_TOPGEN   3392
#define XCD_BAR_WORDS 3456
#define XB_SPIN_CAP (1u << 22)
DI unsigned xb_ld(unsigned* p)              { return __hip_atomic_load(p, __ATOMIC_RELAXED, __HIP_MEMORY_SCOPE_AGENT); }
DI unsigned xb_add(unsigned* p, unsigned v) { return __hip_atomic_fetch_add(p, v, __ATOMIC_RELAXED, __HIP_MEMORY_SCOPE_AGENT); }
DI unsigned xb_xcc_id() { return (unsigned)__builtin_amdgcn_s_getreg((3 << 11) | 20) & 0xFu; }
#define XB_SPIN(cond, bar) do { unsigned _sp = 0; while (cond) { __builtin_amdgcn_s_sleep(1); \
    if ((++_sp & 255u) == 0u) { if (xb_ld(&(bar)[XB_TMO])) break; if (_sp > XB_SPIN_CAP) { atomicAdd(&(bar)[XB_TMO], 1u); break; } } } } while (0)
struct XcdBarrier { unsigned* bar; unsigned x; volatile LAS unsigned* st; };
DI XcdBarrier xcd_barrier_post(unsigned* bar, volatile LAS unsigned* st) {
    XcdBarrier b; b.bar = bar; b.x = xb_xcc_id(); b.st = st;
    if (threadIdx.x == 0) (void)xb_add(&bar[XB_XCNT(b.x)], 1u);
    return b;
}
DI void xcd_barrier_complete(unsigned* bar, unsigned x, unsigned& nloc, unsigned& nx) {
    const unsigned G = gridDim.x * gridDim.y * gridDim.z;
    unsigned sum, cnt, mine, sp = 0u;
    for (;;) {
        sum = 0u; cnt = 0u; mine = 0u;
#pragma unroll
        for (unsigned j = 0; j < 16; ++j) { const unsigned c = xb_ld(&bar[XB_XCNT(j)]); sum += c; cnt += (c > 0u) ? 1u : 0u; mine = (j == x) ? c : mine; }
        if (sum == G) break;
        __builtin_amdgcn_s_sleep(1);
        if ((++sp & 255u) == 0u) { if (xb_ld(&bar[XB_TMO])) break; if (sp > XB_SPIN_CAP) { atomicAdd(&bar[XB_TMO], 1u); break; } }
    }
    nloc = mine > 0u ? mine : 1u; nx = cnt > 0u ? cnt : 1u;
}
DI void xcd_barrier(const XcdBarrier& b) {
    asm volatile("s_waitcnt vmcnt(0)" ::: "memory");
    __syncthreads();
    if (threadIdx.x == 0) {
        unsigned* bar = b.bar;
        __builtin_amdgcn_s_waitcnt(0);
        unsigned nloc = b.st[0], nx = b.st[1];
        if (nloc == 0u) { xcd_barrier_complete(bar, b.x, nloc, nx); b.st[0] = nloc; b.st[1] = nx; }
        const unsigned old = xb_add(&bar[XB_XSUB(b.x)], 1u);
        const unsigned gen = old / nloc;
        if (old + 1u == (gen + 1u) * nloc) {
            __builtin_amdgcn_fence(__ATOMIC_RELEASE, "agent");
            asm volatile("s_waitcnt vmcnt(0)" ::: "memory");
            const unsigned og = xb_add(&bar[XB_TOP], 1u);
            const unsigned tg = og / nx;
            if (og + 1u == (tg + 1u) * nx) xb_add(&bar[XB_TOPGEN], 1u);
            else XB_SPIN(xb_ld(&bar[XB_TOPGEN]) == tg, bar);
            __builtin_amdgcn_fence(__ATOMIC_ACQUIRE, "agent");
            xb_add(&bar[XB_XGEN(b.x)], 1u);
            asm volatile("s_waitcnt vmcnt(0)" ::: "memory");
        } else {
            XB_SPIN(xb_ld(&bar[XB_XGEN(b.x)]) == gen, bar);
            __builtin_amdgcn_fence(__ATOMIC_ACQUIRE, "agent");
            asm volatile("s_waitcnt vmcnt(0)" ::: "memory");
        }
    }
    __syncthreads();
}
constexpr int LDS_MISC_OFF = LDS_BYTES - 64;

__global__ void __launch_bounds__(512, 2) fwd_megakernel(Params P) {
    extern __shared__ __attribute__((aligned(16))) unsigned char lds[];
    cg::grid_group grid = cg::this_grid();
    const float* MOD = (const float*)(P.ws + WS_MOD);
    volatile LAS unsigned* misc = (volatile LAS unsigned*)((LAS unsigned char*)lds + LDS_MISC_OFF);
    if (threadIdx.x < 16) misc[threadIdx.x] = 0u;
    __syncthreads();
    XcdBarrier xbar = xcd_barrier_post((unsigned*)(P.ws + WS_BAR), misc);
    for (int pi = P.ph_lo; pi < P.ph_hi; ++pi) {
        int ph; if (pi == 0) ph = 0; else if (pi == 1 + 9 * NL) ph = NPHASE - 1; else { const int q = pi - 1, pl = q / 9, r = q % 9; ph = 1 + 10 * pl + (r < 8 ? r : 9); }
#if DUPMASK
      const int nrep_ = (ph > 0 && ph < NPHASE - 1 && ((DUPMASK >> ((ph - 1) % 10)) & 1)) ? 2 : 1;
      for (int rep_ = 0; rep_ < nrep_; ++rep_) {
        if (rep_) __syncthreads();
#endif
        if (ph == 0) { if (PHM & 1) phase0(P, lds); }
        else if (ph == NPHASE - 1) { for (int it = blockIdx.x; it < 512; it += gridDim.x) norm_rows_items(P, 0, 2, it); }
        else {
            const int l = (ph - 1) / 10, sp = (ph - 1) % 10;
            if (sp == 0) { if (PHM & 2) phaseA(P, l, lds); }
            else if (sp == 1) { if (PHM & 4) {
                pg8::Gemm g{(const bf16_t*)(P.ws + WS_HB), (const bf16_t*)(P.ws + WS_W1), 1024, 1024, 1024, 0, 0};
                pg8::StaticOrder S; S.init(T, N1, gridDim.x, blockIdx.x, 3);
                pg8::EpiG1 E{(bf16_t*)(P.ws + WS_Z), (bf16_t*)(P.ws + WS_R)};
                pg8::gemm_phase((LAS unsigned char*)lds, g, S, E);

            } } else if (sp == 2) { if (PHM & 8) phaseP2(P, l, lds); }
            else if (sp == 3) { if (PHM & 16) phaseP3(P, l, lds); }
            else if (sp == 4) { if (PHM & 32) {
                pg8::Gemm g{(const bf16_t*)(P.ws + WS_BR), (const bf16_t*)(P.ws + WS_WBR), 1024, 256, 256, (size_t)256 * 2, (size_t)1024 * 256 * 2};
                pg8::StaticOrder S; S.init(T, 1024, gridDim.x, blockIdx.x, 1);
                pg8::EpiMerge E{(const bf16_t*)(P.ws + WS_R), (bf16_t*)(P.ws + WS_HB)};
                pg8::gemm_phase((LAS unsigned char*)lds, g, S, E);
            } } else if (sp == 5) { if (PHM & 64) {
                pg8::Gemm g{(const bf16_t*)(P.ws + WS_HB), (const bf16_t*)(P.ws + WS_WOUT), 1024, 1024, 1024, 0, 0};
                pg8::StaticOrder S; S.init(T, 1024, gridDim.x, blockIdx.x, 0);
                pg8::EpiRes<1> E{P.out, MOD + (size_t)l * 9 * 6144 + 2048, (bf16_t*)(P.ws + WS_Z)};
                pg8::gemm_phase((LAS unsigned char*)lds, g, S, E);
            } } else if (sp == 6) { for (int it = blockIdx.x; it < 512; it += gridDim.x) norm_rows_items(P, l, 1, it); }
            else if (sp == 7) { if (PHM & 128) {
                pg8::Gemm g{(const bf16_t*)(P.ws + WS_HB) - 1024, (const bf16_t*)(P.ws + WS_WUG), 1024, 1024, 1024, 0, 0, 254};
                pg8::StaticOrder S; S.init(65 * 256, 5632, gridDim.x, blockIdx.x, 0);
                pg8::EpiConv E{(bf16_t*)(P.ws + WS_ACT), P.in[37] + (size_t)l * 3 * FF, P.in[38] + (size_t)l * FF, (float*)(lds + 131072)};
                pg8::gemm_phase((LAS unsigned char*)lds, g, S, E);
            } } else if (sp == 8) { if (PHM & 256) phaseAct(P, l); }
            else { if (PHM & 512) {
                pg8::Gemm g{(const bf16_t*)(P.ws + WS_ACT), (const bf16_t*)(P.ws + WS_WFD), FF, FF, FF, 0, 0};
                pg8::StaticOrder S; S.init(T, 1024, gridDim.x, blockIdx.x, 0);
                pg8::EpiRes<2> E{P.out, MOD + (size_t)l * 9 * 6144 + 5120, (bf16_t*)(P.ws + WS_Z)};
                pg8::gemm_phase((LAS unsigned char*)lds, g, S, E);
            } }
        }
        if (ph > 0 && ph < NPHASE - 1) {
            const int l = (ph - 1) / 10, sp = (ph - 1) % 10; int first, stride;
            if (sp == 7 && l + 1 < NL) { idle_slice(65 * 22, first, stride); conv_items(P, l + 1, 0, first, stride, lds); }
        }
#if DUPMASK
      }
#endif
        if (pi + 1 < P.ph_hi) {
            if (P.ph_hi < 0) grid.sync();
            xcd_barrier(xbar);
#if DUPSYNC
            xcd_barrier(xbar); xcd_barrier(xbar);
#endif
        }
    }
}

#ifndef MK_PER_PHASE
#define MK_PER_PHASE 0
#endif
extern "C" void kernel_launch(void* const* d_in, const int* in_sizes, int n_in, void* d_out, int out_size, void* d_ws, size_t ws_size, hipStream_t stream) {
    static int grid = 0;
    if (grid == 0) {
        int dev = 0, cus = 0, per_cu = 0;
        hipGetDevice(&dev); hipDeviceGetAttribute(&cus, hipDeviceAttributeMultiprocessorCount, dev);
        if (hipFuncSetAttribute((const void*)fwd_megakernel, hipFuncAttributeMaxDynamicSharedMemorySize, LDS_BYTES) != hipSuccess) { fprintf(stderr, "hipFuncSetAttribute failed\n"); grid = -1; return; }
        hipOccupancyMaxActiveBlocksPerMultiprocessor(&per_cu, (const void*)fwd_megakernel, 512, LDS_BYTES);
        if (per_cu < 1) { fprintf(stderr, "occupancy query says %d blocks/CU\n", per_cu); per_cu = 1; }
        (void)hipGetLastError();
        grid = cus * per_cu;
        if (n_in != 41 || ws_size < WS_END) { fprintf(stderr, "kernel_launch: n_in %d ws %zu (need %zu)\n", n_in, ws_size, (size_t)WS_END); grid = -1; return; }
    }
    if (grid < 0) return;
    if (hipMemsetAsync((char*)d_ws + WS_BAR, 0, 32768, stream) != hipSuccess) { fprintf(stderr, "memset of barrier words failed\n"); return; }
    Params p{};
    for (int i = 0; i < 41; ++i) p.in[i] = (const float*)d_in[i];
    p.out = (float*)d_out; p.ws = (unsigned char*)d_ws;
#if MK_PER_PHASE
    for (int ph = 0; ph < NPHASE; ++ph) { p.ph_lo = ph; p.ph_hi = ph + 1; hipLaunchKernelGGL(fwd_megakernel, dim3(grid), dim3(512), LDS_BYTES, stream, p); }
#else
    p.ph_lo = 0; p.ph_hi = 2 + 9 * NL;
    void* args[] = {&p};
    hipError_t e = hipLaunchCooperativeKernel((const void*)fwd_megakernel, dim3(grid), dim3(512), args, LDS_BYTES, stream);
    if (e != hipSuccess) fprintf(stderr, "cooperative launch failed: %s (grid %d)\n", hipGetErrorString(e), grid);
#endif
}
```
